# Optimizing an MI355X kernel written in HIP

```python
import jax, jax.numpy as jnp
from jax import lax
import numpy as np

D_MODEL = 4096
BATCH = 1
SEQ = 8192
DEPTH = 2

N_BRANCH = 4
BRANCH_W = D_MODEL // 4
MLSTM_HEADS = 8
MLSTM_DH = BRANCH_W // MLSTM_HEADS
MLSTM_CHUNK = 128
GMLP_GROUPS = 8
GMLP_GW = BRANCH_W // GMLP_GROUPS
GMLP_CHUNK = 128
RGLRU_BLOCKS = 8
RGLRU_BW = BRANCH_W // RGLRU_BLOCKS
RGLRU_CONV = 4
RGLRU_C = 8.0
SCONV_K = 3
EPS = 1e-6

SPLIT_SIZES = (
    5 * BRANCH_W + 2 * MLSTM_HEADS,
    3 * BRANCH_W,
    2 * BRANCH_W,
    4 * BRANCH_W,
    N_BRANCH * D_MODEL,
)
SPLIT_POINTS = tuple(int(p) for p in np.cumsum(SPLIT_SIZES)[:-1])
PROJ_W = sum(SPLIT_SIZES)

kernel_name = 'hybrid_gated_parallel_mixers'


def rms_norm(x, w):
    xf = x.astype(jnp.float32)
    y = xf * lax.rsqrt(jnp.mean(xf * xf, axis=-1, keepdims=True) + EPS)
    return (y * w.astype(jnp.float32)).astype(x.dtype)


def layer_norm(x, w, b):
    xf = x.astype(jnp.float32)
    mu = jnp.mean(xf, axis=-1, keepdims=True)
    xc = xf - mu
    var = jnp.mean(xc * xc, axis=-1, keepdims=True)
    return (xc * lax.rsqrt(var + EPS) * w.astype(jnp.float32) + b.astype(jnp.float32)).astype(x.dtype)


def causal_dwconv(x, w):
    K = w.shape[0]
    S = x.shape[1]
    xp = jnp.pad(x, ((0, 0), (K - 1, 0), (0, 0)))
    y = xp[:, 0:S] * w[0]
    for k in range(1, K):
        y = y + xp[:, k:k + S] * w[k]
    return y


def mlstm_chunkwise(q, k, v, i_pre, f_pre):
    B, S, NH, DH = q.shape
    L = MLSTM_CHUNK
    NC = S // L
    k = k * (DH ** -0.5)
    lf = jax.nn.log_sigmoid(f_pre)

    def to_chunks(t):
        return t.reshape(B, NC, L, NH, DH).transpose(1, 0, 3, 2, 4)

    def gate_chunks(t):
        return t.reshape(B, NC, L, NH).transpose(1, 0, 3, 2)

    tril = jnp.tril(jnp.ones((L, L), dtype=bool))

    def step(carry, xs):
        C, n, m = carry
        qc, kc, vc, ic, fc = xs
        b = jnp.cumsum(fc, axis=-1)
        inter = b + m[..., None]
        dmat = jnp.where(tril, b[..., :, None] - b[..., None, :] + ic[..., None, :], -jnp.inf)
        m_t = jnp.maximum(inter, jnp.max(dmat, axis=-1))
        w_intra = jnp.exp(dmat - m_t[..., None])
        w_inter = jnp.exp(inter - m_t)
        scores = jnp.einsum('bhtd,bhsd->bhts', qc, kc) * w_intra
        num = jnp.einsum('bhts,bhse->bhte', scores, vc) + w_inter[..., None] * jnp.einsum('bhed,bhtd->bhte', C, qc)
        den = jnp.sum(scores, axis=-1) + w_inter * jnp.einsum('bhd,bhtd->bht', n, qc)
        h = num / jnp.maximum(jnp.abs(den), jnp.exp(-m_t))[..., None]
        b_last = b[..., -1]
        w_src = b_last[..., None] - b + ic
        m_new = jnp.maximum(b_last + m, jnp.max(w_src, axis=-1))
        decay = jnp.exp(b_last + m - m_new)
        ws = jnp.exp(w_src - m_new[..., None])
        C_new = decay[..., None, None] * C + jnp.einsum('bhs,bhse,bhsd->bhed', ws, vc, kc)
        n_new = decay[..., None] * n + jnp.einsum('bhs,bhsd->bhd', ws, kc)
        return (C_new, n_new, m_new), h

    init = (jnp.zeros((B, NH, DH, DH), jnp.float32),
            jnp.zeros((B, NH, DH), jnp.float32),
            jnp.zeros((B, NH), jnp.float32))
    xs = (to_chunks(q), to_chunks(k), to_chunks(v), gate_chunks(i_pre), gate_chunks(lf))
    _, h = lax.scan(step, init, xs)
    return h.transpose(1, 0, 3, 2, 4).reshape(B, S, NH * DH)


def rglru_scan(x, r_pre, i_pre, a_param):
    xf = x.astype(jnp.float32)
    r = jax.nn.sigmoid(r_pre.astype(jnp.float32))
    ig = jax.nn.sigmoid(i_pre.astype(jnp.float32))
    log_a = -RGLRU_C * r * jax.nn.softplus(-a_param.astype(jnp.float32))
    a = jnp.exp(log_a)
    mult = jnp.sqrt(-jnp.expm1(2.0 * log_a))
    first = (jnp.arange(x.shape[1]) == 0)[None, :, None]
    mult = jnp.where(first, 1.0, mult)
    bx = mult * ig * xf

    def combine(lhs, rhs):
        a1, b1 = lhs
        a2, b2 = rhs
        return a1 * a2, a2 * b1 + b2

    _, h = lax.associative_scan(combine, (a, bx), axis=1)
    return h.astype(x.dtype)


def hybrid_layer(x, pre_w, post_w, w_in, mlstm_gate_bias, mlstm_norm_w, gmlp_ln_w, gmlp_ln_b,
                 gmlp_w_s, gmlp_b_s, rglru_conv_w, rglru_conv_b, rglru_w_gate, rglru_b_gate,
                 rglru_a_param, sconv_w, w_branch, w_out):
    B, S, _ = x.shape
    h = rms_norm(x, pre_w)
    proj = h @ w_in
    p_a, p_b, p_c, p_d, p_g = jnp.split(proj, SPLIT_POINTS, axis=-1)

    q, k, v, o, z_a = jnp.split(p_a[..., :5 * BRANCH_W], 5, axis=-1)
    gates = p_a[..., 5 * BRANCH_W:].astype(jnp.float32) + mlstm_gate_bias.astype(jnp.float32)
    i_pre, f_pre = gates[..., :MLSTM_HEADS], gates[..., MLSTM_HEADS:]
    heads = lambda t: t.astype(jnp.float32).reshape(B, S, MLSTM_HEADS, MLSTM_DH)
    y_a = mlstm_chunkwise(heads(q), heads(k), heads(v), i_pre, f_pre)
    y_a = rms_norm(y_a.reshape(B, S, MLSTM_HEADS, MLSTM_DH),
                   mlstm_norm_w.reshape(MLSTM_HEADS, MLSTM_DH)).reshape(B, S, BRANCH_W)
    y_a = (y_a * jax.nn.sigmoid(o.astype(jnp.float32))).astype(x.dtype) * jax.nn.silu(z_a)

    u, vg, z_b = jnp.split(p_b, 3, axis=-1)
    vg = layer_norm(vg, gmlp_ln_w, gmlp_ln_b).reshape(B, S // GMLP_CHUNK, GMLP_CHUNK, GMLP_GROUPS, GMLP_GW)
    w_causal = jnp.tril(gmlp_w_s)
    sp = jnp.einsum('gts,bnsgc->bntgc', w_causal, vg) + gmlp_b_s.T[None, None, :, :, None]
    y_b = u * sp.reshape(B, S, BRANCH_W) * jax.nn.silu(z_b)

    xc, z_c = jnp.split(p_c, 2, axis=-1)
    xc = causal_dwconv(xc, rglru_conv_w) + rglru_conv_b
    gt = jnp.einsum('bsnc,ncd->bsnd', xc.reshape(B, S, RGLRU_BLOCKS, RGLRU_BW), rglru_w_gate)
    r_pre = gt[..., :RGLRU_BW].reshape(B, S, BRANCH_W) + rglru_b_gate[:BRANCH_W]
    ri_pre = gt[..., RGLRU_BW:].reshape(B, S, BRANCH_W) + rglru_b_gate[BRANCH_W:]
    y_c = rglru_scan(xc, r_pre, ri_pre, rglru_a_param) * jax.nn.silu(z_c)

    bg, cg, xd, z_d = jnp.split(p_d, 4, axis=-1)
    y_d = bg * causal_dwconv(cg * xd, sconv_w) * jax.nn.silu(z_d)

    ys = jnp.stack([y_a, y_b, y_c, y_d], axis=2)
    branch = jnp.einsum('bsgc,gcd->bsgd', ys, w_branch)
    gate = jax.nn.sigmoid(p_g.reshape(B, S, N_BRANCH, D_MODEL))
    merged = jnp.einsum('bsgd,bsgd->bsd', gate, branch)
    out = merged @ w_out
    return x + rms_norm(out, post_w)


def setup_inputs(seed: int = 0) -> dict:
    key = jax.random.key(seed)
    ks = jax.random.split(key, 20)
    f32 = jnp.float32
    nrm = lambda k, shape, s: jax.random.normal(k, shape, f32) * s
    x = jax.random.normal(ks[0], (BATCH, SEQ, D_MODEL), f32)
    pre_w = 1.0 + nrm(ks[1], (DEPTH, D_MODEL), 0.1)
    post_w = 1.0 + nrm(ks[2], (DEPTH, D_MODEL), 0.1)
    w_in = nrm(ks[3], (DEPTH, D_MODEL, PROJ_W), D_MODEL ** -0.5)
    f_bias = jnp.linspace(3.0, 6.0, MLSTM_HEADS, dtype=f32)
    mlstm_gate_bias = jnp.concatenate([
        nrm(ks[4], (DEPTH, MLSTM_HEADS), 0.1),
        f_bias[None, :] + nrm(ks[5], (DEPTH, MLSTM_HEADS), 0.1)], axis=-1)
    mlstm_norm_w = 1.0 + nrm(ks[6], (DEPTH, BRANCH_W), 0.1)
    gmlp_ln_w = 1.0 + nrm(ks[7], (DEPTH, BRANCH_W), 0.1)
    gmlp_ln_b = nrm(ks[8], (DEPTH, BRANCH_W), 0.01)
    gmlp_w_s = nrm(ks[9], (DEPTH, GMLP_GROUPS, GMLP_CHUNK, GMLP_CHUNK), GMLP_CHUNK ** -0.5)
    gmlp_b_s = 1.0 + nrm(ks[10], (DEPTH, GMLP_GROUPS, GMLP_CHUNK), 0.1)
    rglru_conv_w = nrm(ks[11], (DEPTH, RGLRU_CONV, BRANCH_W), RGLRU_CONV ** -0.5)
    rglru_conv_b = nrm(ks[12], (DEPTH, BRANCH_W), 0.01)
    rglru_w_gate = nrm(ks[13], (DEPTH, RGLRU_BLOCKS, RGLRU_BW, 2 * RGLRU_BW), RGLRU_BW ** -0.5)
    rglru_b_gate = nrm(ks[14], (DEPTH, 2 * BRANCH_W), 0.01)
    u = jax.random.uniform(ks[15], (DEPTH, BRANCH_W), f32, 0.9, 0.999)
    s = u ** (1.0 / RGLRU_C)
    rglru_a_param = jnp.log(s) - jnp.log1p(-s)
    sconv_w = nrm(ks[16], (DEPTH, SCONV_K, BRANCH_W), SCONV_K ** -0.5)
    w_branch = nrm(ks[17], (DEPTH, N_BRANCH, BRANCH_W, D_MODEL), BRANCH_W ** -0.5)
    w_out = nrm(ks[18], (DEPTH, D_MODEL, D_MODEL), D_MODEL ** -0.5)
    return {'x': x, 'pre_w': pre_w, 'post_w': post_w, 'w_in': w_in,
            'mlstm_gate_bias': mlstm_gate_bias, 'mlstm_norm_w': mlstm_norm_w,
            'gmlp_ln_w': gmlp_ln_w, 'gmlp_ln_b': gmlp_ln_b, 'gmlp_w_s': gmlp_w_s, 'gmlp_b_s': gmlp_b_s,
            'rglru_conv_w': rglru_conv_w, 'rglru_conv_b': rglru_conv_b, 'rglru_w_gate': rglru_w_gate,
            'rglru_b_gate': rglru_b_gate, 'rglru_a_param': rglru_a_param, 'sconv_w': sconv_w,
            'w_branch': w_branch, 'w_out': w_out}


def reference(x, pre_w, post_w, w_in, mlstm_gate_bias, mlstm_norm_w, gmlp_ln_w, gmlp_ln_b,
              gmlp_w_s, gmlp_b_s, rglru_conv_w, rglru_conv_b, rglru_w_gate, rglru_b_gate,
              rglru_a_param, sconv_w, w_branch, w_out):
    for l in range(DEPTH):
        x = hybrid_layer(x, pre_w[l], post_w[l], w_in[l], mlstm_gate_bias[l], mlstm_norm_w[l],
                         gmlp_ln_w[l], gmlp_ln_b[l], gmlp_w_s[l], gmlp_b_s[l], rglru_conv_w[l],
                         rglru_conv_b[l], rglru_w_gate[l], rglru_b_gate[l], rglru_a_param[l],
                         sconv_w[l], w_branch[l], w_out[l])
    return x
```

```cpp
#include <hip/hip_runtime.h>
#include <cstdio>
#include <cstdint>

#define LAS __attribute__((address_space(3)))
#define GAS __attribute__((address_space(1)))
typedef unsigned short bf16_t;
typedef short bf16x8 __attribute__((ext_vector_type(8)));
typedef short bf16x4 __attribute__((ext_vector_type(4)));
typedef float f32x4 __attribute__((ext_vector_type(4)));
typedef float f32x2 __attribute__((ext_vector_type(2)));
typedef unsigned u32x4 __attribute__((ext_vector_type(4)));
typedef unsigned u32x2 __attribute__((ext_vector_type(2)));
typedef LAS unsigned char lds_u8;

constexpr int DM = 4096, SEQ = 8192, DEPTH = 2, BW = 1024, NHEAD = 8, LCH = 128, NCH = 64;
constexpr int PROJ_W = 30736, NP = 30720;
constexpr int C_Q = 0, C_K = 1024, C_V = 2048, C_O = 3072, C_ZA = 4096, C_U = 5120, C_VG = 6144, C_ZB = 7168, C_XC = 8192, C_ZC = 9216,
              C_BG = 10240, C_CG = 11264, C_XD = 12288, C_ZD = 13312, C_G = 14336;
constexpr float EPS = 1e-6f;

constexpr size_t MiB = 1u << 20;
constexpr size_t WS_CTL = 0, CTL_ZERO_BYTES = 1 * MiB;
constexpr size_t WS_WIN = 16 * MiB;
constexpr size_t WIN_L = (size_t)NP * DM * 2;
constexpr size_t WS_WBR = 496 * MiB;
constexpr size_t WS_WOUT = 560 * MiB;
constexpr size_t WSQ_L = (size_t)DM * DM * 2;
constexpr size_t WS_WG = 624 * MiB;
constexpr size_t WS_GWT = 625 * MiB;
constexpr size_t WS_RWT = 626 * MiB;
constexpr size_t WS_H = 640 * MiB;
constexpr size_t WS_PROJ = 704 * MiB;
constexpr size_t WS_YS = 1184 * MiB;
constexpr size_t WS_MERGED = 1248 * MiB;
constexpr size_t WS_OUT = 1312 * MiB;
constexpr size_t WS_X1 = 1440 * MiB;
constexpr size_t WS_SS = 1568 * MiB;
constexpr size_t WS_GATES = 1570 * MiB;
constexpr size_t WS_TB = 1571 * MiB;
constexpr size_t WS_DC = 1576 * MiB;
constexpr size_t WS_DN = 1608 * MiB;
constexpr size_t WS_CST = 1610 * MiB;
constexpr size_t WS_NST = 1626 * MiB;
constexpr size_t WS_HLOC = 1628 * MiB;
constexpr size_t WS_ACUM = 1660 * MiB;
constexpr size_t WS_APROD = 1692 * MiB;
constexpr size_t WS_END = 1696 * MiB;
constexpr int CW_BAR = 4096;

constexpr int LDS_BYTES = 147456;
constexpr int MISC_OFF = LDS_BYTES - 256;
constexpr int TP = 272;
constexpr int TILE_B = 128 * TP;
constexpr int SP = 132;
constexpr int SCAL_OFF = 4 * TILE_B;

__device__ __forceinline__ float bf2f(unsigned short b) { return __uint_as_float(((unsigned)b) << 16); }
__device__ __forceinline__ unsigned f2bf(float f) { unsigned u = __float_as_uint(f); return (u + 0x7fffu + ((u >> 16) & 1u)) >> 16; }
__device__ __forceinline__ unsigned pk2(float lo, float hi) { return f2bf(lo) | (f2bf(hi) << 16); }
__device__ __forceinline__ unsigned cvt_pk_bf16(float lo, float hi) { unsigned r; asm volatile("v_cvt_pk_bf16_f32 %0, %1, %2" : "=v"(r) : "v"(lo), "v"(hi)); return r; }
__device__ __forceinline__ void unpack8(const u32x4 v, float (&f)[8]) {
    f[0] = __uint_as_float(v.x << 16); f[1] = __uint_as_float(v.x & 0xffff0000u); f[2] = __uint_as_float(v.y << 16); f[3] = __uint_as_float(v.y & 0xffff0000u);
    f[4] = __uint_as_float(v.z << 16); f[5] = __uint_as_float(v.z & 0xffff0000u); f[6] = __uint_as_float(v.w << 16); f[7] = __uint_as_float(v.w & 0xffff0000u);
}
__device__ __forceinline__ u32x4 pack8(const float (&f)[8]) { u32x4 w; w.x = pk2(f[0], f[1]); w.y = pk2(f[2], f[3]); w.z = pk2(f[4], f[5]); w.w = pk2(f[6], f[7]); return w; }
__device__ __forceinline__ float wave_sum(float v) {
#pragma unroll
    for (int o = 1; o < 64; o <<= 1) v += __shfl_xor(v, o);
    return v;
}
__device__ __forceinline__ float sigmoidf_(float x) { return __builtin_amdgcn_rcpf(1.0f + __builtin_amdgcn_exp2f(-1.44269504f * x)); }
#define LDS_WAIT() asm volatile("s_waitcnt lgkmcnt(0)" ::: "memory")
#define VM_WAIT() asm volatile("s_waitcnt vmcnt(0)" ::: "memory")

#define XB_TMO      128
#define XB_XCNT(j)  (256  + 64 * (j))
#define XB_XSUB(j)  (1280 + 64 * (j))
#define XB_XGEN(j)  (2304 + 64 * (j))
#define XB_TOP      3328
#define XB_TOPGEN   3392
#define XCD_BAR_WORDS 3456
#define XB_SPIN_CAP (1u << 18)

__device__ __forceinline__ unsigned xb_ld(unsigned* p)              { return __hip_atomic_load(p, __ATOMIC_RELAXED, __HIP_MEMORY_SCOPE_AGENT); }
__device__ __forceinline__ unsigned xb_add(unsigned* p, unsigned v) { return __hip_atomic_fetch_add(p, v, __ATOMIC_RELAXED, __HIP_MEMORY_SCOPE_AGENT); }
__device__ __forceinline__ unsigned xb_xcc_id() { return (unsigned)__builtin_amdgcn_s_getreg((3 << 11) | 20) & 0xFu; }
#define XB_SPIN(cond, bar) do { unsigned _sp = 0; while (cond) { __builtin_amdgcn_s_sleep(1); \
    if ((++_sp & 255u) == 0u) { if (xb_ld(&(bar)[XB_TMO])) break; if (_sp > XB_SPIN_CAP) { atomicAdd(&(bar)[XB_TMO], 1u); break; } } } } while (0)

struct XcdBarrier { unsigned* bar; unsigned x; volatile LAS unsigned* st; };

__device__ __forceinline__ XcdBarrier xcd_barrier_post(unsigned* bar, volatile LAS unsigned* st) {
    XcdBarrier b; b.bar = bar; b.x = xb_xcc_id(); b.st = st;
    if (threadIdx.x == 0) (void)xb_add(&bar[XB_XCNT(b.x)], 1u);
    return b;
}
__device__ __forceinline__ void xcd_barrier_complete(unsigned* bar, unsigned x, unsigned& nloc, unsigned& nx) {
    const unsigned G = gridDim.x * gridDim.y * gridDim.z;
    unsigned sum, cnt, mine, sp = 0u;
    for (;;) {
        sum = 0u; cnt = 0u; mine = 0u;
#pragma unroll
        for (unsigned j = 0; j < 16; ++j) { const unsigned c = xb_ld(&bar[XB_XCNT(j)]); sum += c; cnt += (c > 0u) ? 1u : 0u; mine = (j == x) ? c : mine; }
        if (sum == G) break;
        __builtin_amdgcn_s_sleep(1);
        if ((++sp & 255u) == 0u) { if (xb_ld(&bar[XB_TMO])) break; if (sp > XB_SPIN_CAP) { atomicAdd(&bar[XB_TMO], 1u); break; } }
    }
    nloc = mine > 0u ? mine : 1u; nx = cnt > 0u ? cnt : 1u;
}
__device__ __forceinline__ void xcd_barrier(const XcdBarrier& b) {
    asm volatile("s_waitcnt vmcnt(0)" ::: "memory");
    __syncthreads();
    if (threadIdx.x == 0) {
        unsigned* bar = b.bar;
        __builtin_amdgcn_s_waitcnt(0);
        unsigned nloc = b.st[0], nx = b.st[1];
        if (nloc == 0u) { xcd_barrier_complete(bar, b.x, nloc, nx); b.st[0] = nloc; b.st[1] = nx; }
        const unsigned old = xb_add(&bar[XB_XSUB(b.x)], 1u);
        const unsigned gen = old / nloc;
        if (old + 1u == (gen + 1u) * nloc) {
            __builtin_amdgcn_fence(__ATOMIC_RELEASE, "agent");
            asm volatile("s_waitcnt vmcnt(0)" ::: "memory");
            const unsigned og = xb_add(&bar[XB_TOP], 1u);
            const unsigned tg = og / nx;
            if (og + 1u == (tg + 1u) * nx) xb_add(&bar[XB_TOPGEN], 1u);
            else XB_SPIN(xb_ld(&bar[XB_TOPGEN]) == tg, bar);
            __builtin_amdgcn_fence(__ATOMIC_ACQUIRE, "agent");
            xb_add(&bar[XB_XGEN(b.x)], 1u);
            asm volatile("s_waitcnt vmcnt(0)" ::: "memory");
        } else {
            XB_SPIN(xb_ld(&bar[XB_XGEN(b.x)]) == gen, bar);
            __builtin_amdgcn_fence(__ATOMIC_ACQUIRE, "agent");
            asm volatile("s_waitcnt vmcnt(0)" ::: "memory");
        }
    }
    __syncthreads();
}

namespace pg8 {
constexpr int BM = 256, BK = 64, HALF = 128, HTB = HALF * BK * 2, STAGE_BYTES = 8 * HTB, NXCD = 8, WGM = 8;
__host__ __device__ __forceinline__ int lds_byte(int r, int c) { const int st = (r >> 4) * 2 + (c >> 5), rr = r & 15, cc = c & 31, ob = rr * 64 + cc * 2; return st * 1024 + (ob ^ (((ob >> 9) & 1) << 5)); }
__host__ __device__ __forceinline__ void stage_rc(int b, int& R, int& C) { const int st = b / 1024, sb = b % 1024, swz = sb ^ (((sb >> 9) & 1) << 5); R = (st >> 1) * 16 + swz / 64; C = (st & 1) * 32 + (swz % 64) / 2; }
__host__ __device__ __forceinline__ int perm32(int rho) { const int n = rho >> 4, i = rho & 15; return 8 * (i >> 2) + 4 * n + (i & 3); }

struct Unit { int pm, pn, g; };
struct Gemm { const bf16_t* A; const bf16_t* Bt; int lda, ldb, K; };

struct StaticOrder {
    int nM, nN, nwg, G, c, gdiv;
    __device__ void init(int M, int N, int G_, int c_, int gdiv_) { nM = M / BM; nN = N / BM; nwg = nM * nN; G = G_; c = c_; gdiv = gdiv_; }
    __device__ bool next(int i, Unit& u) const {
        const int ti = i / gdiv; u.g = i - ti * gdiv;
        const long L = (long)ti * G + c; if (L >= nwg) return false;
        int wgid = (int)L; { const int q = nwg / NXCD, r = nwg % NXCD, xcd = wgid % NXCD, off = wgid / NXCD; wgid = (xcd < r ? xcd * (q + 1) : r * (q + 1) + (xcd - r) * q) + off; }
        const int nig = WGM * nN, gid = wgid / nig, fm = gid * WGM, gsz = (nM - fm) < WGM ? (nM - fm) : WGM;
        u.pm = fm + ((wgid % nig) % gsz); u.pn = (wgid % nig) / gsz; return true;
    }
};


struct EpiProj {
    static constexpr bool PERM = true;
    bf16_t* O;
    __device__ __forceinline__ void operator()(const f32x4 (&acc)[2][2][4][2], const Unit& u, int wr, int wc, int fr, int fq) const {
        const int row0 = u.pm * BM + wr * 64 + fr, col0 = u.pn * BM + wc * 32 + 8 * fq;
        const int seg = u.pn >> 2;
        const int mode = (seg == 3 || seg >= 14) ? 1 : ((seg == 4 || seg == 7 || seg == 9 || seg == 13) ? 2 : 0);
#pragma unroll
        for (int ai = 0; ai < 2; ++ai)
#pragma unroll
            for (int m = 0; m < 4; ++m) { bf16_t* rowp = O + (size_t)(row0 + ai * HALF + m * 16) * NP + col0;
#pragma unroll
                for (int bj = 0; bj < 2; ++bj) { f32x4 v0 = acc[ai][bj][m][0], v1 = acc[ai][bj][m][1];
                    if (mode != 0) {
#pragma unroll
                        for (int j = 0; j < 4; ++j) { const float s0 = sigmoidf_(v0[j]), s1 = sigmoidf_(v1[j]); v0[j] = (mode == 1) ? s0 : v0[j] * s0; v1[j] = (mode == 1) ? s1 : v1[j] * s1; }
                    }
                    u32x4 w; w.x = cvt_pk_bf16(v0[0], v0[1]); w.y = cvt_pk_bf16(v0[2], v0[3]); w.z = cvt_pk_bf16(v1[0], v1[1]); w.w = cvt_pk_bf16(v1[2], v1[3]);
                    *(u32x4*)(rowp + bj * HALF) = w; } }
    }
};
struct EpiMerge {
    static constexpr bool PERM = true;
    const bf16_t* G; float* M32; bf16_t* MERGED;
    __device__ __forceinline__ void operator()(const f32x4 (&acc)[2][2][4][2], const Unit& u, int wr, int wc, int fr, int fq) const {
        const int row0 = u.pm * BM + wr * 64 + fr, col0 = u.pn * BM + wc * 32 + 8 * fq;
        const int g = u.g;
#pragma unroll
        for (int ai = 0; ai < 2; ++ai)
#pragma unroll
            for (int m = 0; m < 4; ++m) { const size_t r = (size_t)(row0 + ai * HALF + m * 16);
#pragma unroll
                for (int bj = 0; bj < 2; ++bj) { const int c = col0 + bj * HALF;
                    const u32x4 gw = *(const u32x4*)(G + r * NP + (size_t)g * DM + c);
                    float gf[8]; unpack8(gw, gf);
                    f32x4 v0 = acc[ai][bj][m][0], v1 = acc[ai][bj][m][1];
                    v0[0] *= gf[0]; v0[1] *= gf[1]; v0[2] *= gf[2]; v0[3] *= gf[3]; v1[0] *= gf[4]; v1[1] *= gf[5]; v1[2] *= gf[6]; v1[3] *= gf[7];
                    float* mp = M32 + r * DM + c;
                    if (g > 0) { v0 += *(const f32x4*)mp; v1 += *(const f32x4*)(mp + 4); }
                    if (g < 3) { *(f32x4*)mp = v0; *(f32x4*)(mp + 4) = v1; }
                    else { u32x4 w; w.x = cvt_pk_bf16(v0[0], v0[1]); w.y = cvt_pk_bf16(v0[2], v0[3]); w.z = cvt_pk_bf16(v1[0], v1[1]); w.w = cvt_pk_bf16(v1[2], v1[3]);
                        *(u32x4*)(MERGED + r * DM + c) = w; } }
                asm volatile("" ::: "memory"); }
    }
};
struct EpiOut {
    static constexpr bool PERM = false;
    float* OUT; float* SS;
    __device__ __forceinline__ void operator()(const f32x4 (&acc)[2][2][4][2], const Unit& u, int wr, int wc, int fr, int fq) const {
        const int row0 = u.pm * BM + wr * 64 + fr, col0 = u.pn * BM + wc * 32 + 4 * fq;
#pragma unroll
        for (int ai = 0; ai < 2; ++ai)
#pragma unroll
            for (int m = 0; m < 4; ++m) { const size_t r = (size_t)(row0 + ai * HALF + m * 16); float* rowp = OUT + r * DM + col0; float q = 0.f;
#pragma unroll
                for (int bj = 0; bj < 2; ++bj)
#pragma unroll
                    for (int n = 0; n < 2; ++n) { const f32x4 v = acc[ai][bj][m][n]; *(f32x4*)(rowp + bj * HALF + n * 16) = v; q += (v[0] * v[0] + v[1] * v[1]) + (v[2] * v[2] + v[3] * v[3]); }
                q += __shfl_xor(q, 16); q += __shfl_xor(q, 32);
                if (fq == 0) SS[r * 64 + u.pn * 4 + wc] = q; }
    }
};

template <class Epi>
__device__ __forceinline__ void gemm_phase(lds_u8* lds, const Gemm g, const StaticOrder& S, const Epi& E) {
    int tid = threadIdx.x; asm volatile("" : "+v"(tid));
    const int wid = __builtin_amdgcn_readfirstlane(tid >> 6), lane = tid & 63, wr = wid >> 2, wc = wid & 3, fr = lane & 15, fq = lane >> 4;
    const int K = g.K, nt = K / BK;
    unsigned voffA[2], voffB[2];
#pragma unroll
    for (int i = 0; i < 2; ++i) { int R, C; stage_rc(tid * 16 + i * 8192, R, C); const int Rb = Epi::PERM ? ((R & ~31) + perm32(R & 31)) : R;
        voffA[i] = (unsigned)(R * g.lda + C) * 2u; voffB[i] = (unsigned)(Rb * g.ldb + C) * 2u; }
    const size_t kstep = (size_t)(BK * 2);
    const size_t hstepA = (size_t)HALF * g.lda * 2, hstepB = (size_t)HALF * g.ldb * 2;
    const size_t tstepA = 2 * hstepA, tstepB = 2 * hstepB;
    const unsigned ldsw = (unsigned)wid * 1024u;
    const int aoff = lds_byte(wr * 64 + fr, fq * 8), boff = lds_byte(wc * 32 + fr, fq * 8);
#define PG8_SA(b, h) (((b) * 2 + (h)) * HTB)
#define PG8_SB(b, h) ((4 + (b) * 2 + (h)) * HTB)
#define PG8_STAGE(bufoff, gbase, voff) do { _Pragma("unroll") for (int _i = 0; _i < 2; ++_i) \
        __builtin_amdgcn_global_load_lds((const unsigned*)((const char*)(gbase) + (voff)[_i]), (LAS unsigned*)(lds + (bufoff) + ldsw + _i * 8192), 16, 0, 0); } while (0)
#define PG8_LDA(dst, b, h) do { _Pragma("unroll") for (int m = 0; m < 4; ++m) _Pragma("unroll") for (int k = 0; k < 2; ++k) dst[m][k] = *(const LAS bf16x8*)(lds + PG8_SA(b, h) + aoff + m * 2048 + k * 1024); } while (0)
#define PG8_LDB(dst, b, h) do { _Pragma("unroll") for (int n = 0; n < 2; ++n) _Pragma("unroll") for (int k = 0; k < 2; ++k) dst[n][k] = *(const LAS bf16x8*)(lds + PG8_SB(b, h) + boff + n * 2048 + k * 1024); } while (0)
#define PG8_MMA(ai, bj, At, Bt) do { __builtin_amdgcn_s_setprio(1); _Pragma("unroll") for (int m = 0; m < 4; ++m) _Pragma("unroll") for (int n = 0; n < 2; ++n) _Pragma("unroll") for (int k = 0; k < 2; ++k) \
        acc[ai][bj][m][n] = __builtin_amdgcn_mfma_f32_16x16x32_bf16(Bt[n][k], At[m][k], acc[ai][bj][m][n], 0, 0, 0); __builtin_amdgcn_s_setprio(0); } while (0)
#define PG8_WAIT_V(n) asm volatile("s_waitcnt vmcnt(" #n ")" ::: "memory")
#define PG8_WAIT_L(n) asm volatile("s_waitcnt lgkmcnt(" #n ")" ::: "memory")
#define PG8_BAR __builtin_amdgcn_s_barrier()
#define PG8_SCHED __builtin_amdgcn_sched_barrier(0)
    Unit cur, nxt; int ui = 0;
    if (!S.next(0, cur)) return;
    f32x4 acc[2][2][4][2];
#pragma unroll
    for (int a = 0; a < 2; ++a)
#pragma unroll
        for (int b = 0; b < 2; ++b)
#pragma unroll
            for (int m = 0; m < 4; ++m)
#pragma unroll
                for (int n = 0; n < 2; ++n) acc[a][b][m][n] = (f32x4){0.f, 0.f, 0.f, 0.f};
    bf16x8 At[4][2], B0[2][2], B1[2][2];
    const char* cA = (const char*)g.A + (size_t)cur.pm * tstepA + (size_t)cur.g * K * 2; const char* cB = (const char*)g.Bt + (size_t)cur.pn * tstepB + (size_t)cur.g * K * 2;
    PG8_STAGE(PG8_SB(0, 0), cB, voffB); PG8_STAGE(PG8_SB(0, 1), cB + hstepB, voffB); PG8_STAGE(PG8_SA(0, 0), cA, voffA); PG8_STAGE(PG8_SA(0, 1), cA + hstepA, voffA);
    if (wr == 1) PG8_BAR;
    PG8_WAIT_V(2); PG8_BAR;
    PG8_STAGE(PG8_SB(1, 0), cB + kstep, voffB); PG8_STAGE(PG8_SA(1, 0), cA + kstep, voffA); PG8_STAGE(PG8_SB(1, 1), cB + hstepB + kstep, voffB);
    PG8_WAIT_V(6); PG8_BAR;
    for (;;) {
        const bool has_next = S.next(ui + 1, nxt);
        const char* nA = has_next ? (const char*)g.A + (size_t)nxt.pm * tstepA + (size_t)nxt.g * K * 2 : cA; const char* nB = has_next ? (const char*)g.Bt + (size_t)nxt.pn * tstepB + (size_t)nxt.g * K * 2 : cB;
        for (int t = 0; t < nt; t += 2) {
            const bool last = (t == nt - 2);
            const char* a1 = cA + (size_t)(t + 1) * kstep;
            const char* a2 = last ? nA : cA + (size_t)(t + 2) * kstep; const char* b2 = last ? nB : cB + (size_t)(t + 2) * kstep;
            const char* a3 = a2 + kstep; const char* b3 = b2 + kstep;
            PG8_LDB(B0, 0, 0); PG8_LDB(B1, 0, 1); PG8_SCHED; PG8_LDA(At, 0, 0); PG8_STAGE(PG8_SA(1, 1), a1 + hstepA, voffA);
            PG8_WAIT_V(8); PG8_WAIT_L(0); PG8_BAR; PG8_MMA(0, 0, At, B0); PG8_MMA(0, 1, At, B1); PG8_BAR; PG8_SCHED;
            PG8_LDA(At, 0, 1); PG8_STAGE(PG8_SB(0, 0), b2, voffB); PG8_STAGE(PG8_SB(0, 1), b2 + hstepB, voffB); PG8_STAGE(PG8_SA(0, 0), a2, voffA);
            PG8_WAIT_V(8); PG8_WAIT_L(0); PG8_BAR; PG8_MMA(1, 0, At, B0); PG8_MMA(1, 1, At, B1); PG8_BAR; PG8_SCHED;
            PG8_LDB(B0, 1, 0); PG8_LDB(B1, 1, 1); PG8_SCHED; PG8_LDA(At, 1, 0); PG8_STAGE(PG8_SA(0, 1), a2 + hstepA, voffA);
            PG8_WAIT_V(8); PG8_WAIT_L(0); PG8_BAR; PG8_MMA(0, 0, At, B0); PG8_MMA(0, 1, At, B1); PG8_BAR; PG8_SCHED;
            PG8_LDA(At, 1, 1); PG8_STAGE(PG8_SB(1, 0), b3, voffB); PG8_STAGE(PG8_SB(1, 1), b3 + hstepB, voffB); PG8_STAGE(PG8_SA(1, 0), a3, voffA);
            PG8_WAIT_V(8); PG8_WAIT_L(0); PG8_BAR; PG8_MMA(1, 0, At, B0); PG8_MMA(1, 1, At, B1); PG8_BAR; PG8_SCHED;
        }
        if (wr == 0) PG8_BAR;
        E(acc, cur, wr, wc, fr, fq);
        if (!has_next) break;
#pragma unroll
        for (int a = 0; a < 2; ++a)
#pragma unroll
            for (int b = 0; b < 2; ++b)
#pragma unroll
                for (int m = 0; m < 4; ++m)
#pragma unroll
                    for (int n = 0; n < 2; ++n) acc[a][b][m][n] = (f32x4){0.f, 0.f, 0.f, 0.f};
        cur = nxt; cA = nA; cB = nB; ++ui;
        if (wr == 1) PG8_BAR;
    }
    PG8_WAIT_V(0);
    PG8_BAR;
#undef PG8_SA
#undef PG8_SB
#undef PG8_STAGE
#undef PG8_LDA
#undef PG8_LDB
#undef PG8_MMA
#undef PG8_WAIT_V
#undef PG8_WAIT_L
#undef PG8_BAR
#undef PG8_SCHED
}
}

struct Frame {
    lds_u8* lds;
    int G, bid;
    const float* in[18];
    float* out;
    unsigned char* ws;
};
struct Args { const float* in[18]; float* out; unsigned char* ws; };

#define PHASE_TID() int tid = threadIdx.x; asm volatile("" : "+v"(tid)); const int lane = tid & 63; const int wave = __builtin_amdgcn_readfirstlane(tid >> 6); (void)lane; (void)wave
__device__ __forceinline__ bf16x8 frag_row(const lds_u8* tile, int pitch, int r0, int k0, int lane) {
    return *(const LAS bf16x8*)(tile + (r0 + (lane & 15)) * pitch + (k0 + (lane >> 4) * 8) * 2);
}
#ifndef TR_NAIVE
#define TR_NAIVE 0
#endif
__device__ __forceinline__ bf16x8 frag_tr(const lds_u8* tile, int pitch, int k0, int n0, int lane) {
#if TR_NAIVE
    bf16x8 f;
#pragma unroll
    for (int j = 0; j < 8; ++j) f[j] = *(const LAS short*)(tile + (k0 + 8 * (lane >> 4) + j) * pitch + (n0 + (lane & 15)) * 2);
    return f;
#else
    const int g = lane >> 4, i = lane & 15, q = i >> 2, p = i & 3;
    const lds_u8* a = tile + (k0 + 8 * g + q) * pitch + (n0 + 4 * p) * 2;
    const bf16x4 lo = __builtin_amdgcn_ds_read_tr16_b64_v4i16((LAS bf16x4*)a);
    const bf16x4 hi = __builtin_amdgcn_ds_read_tr16_b64_v4i16((LAS bf16x4*)(a + 4 * pitch));
    bf16x8 f; f[0] = lo[0]; f[1] = lo[1]; f[2] = lo[2]; f[3] = lo[3]; f[4] = hi[0]; f[5] = hi[1]; f[6] = hi[2]; f[7] = hi[3];
    return f;
#endif
}
template <bool A_TR, bool B_TR>
__device__ __forceinline__ void mm128(f32x4 (&acc)[2][4], const lds_u8* At, const lds_u8* Bt, int wave, int lane) {
    const int rb = (wave >> 1) * 32, cb = (wave & 1) * 64;
#pragma unroll
    for (int mi = 0; mi < 2; ++mi)
#pragma unroll
        for (int ni = 0; ni < 4; ++ni) acc[mi][ni] = (f32x4){0.f, 0.f, 0.f, 0.f};
#pragma unroll
    for (int kk = 0; kk < 4; ++kk) {
        bf16x8 a[2], b[4];
#pragma unroll
        for (int mi = 0; mi < 2; ++mi) a[mi] = A_TR ? frag_tr(At, TP, kk * 32, rb + mi * 16, lane) : frag_row(At, TP, rb + mi * 16, kk * 32, lane);
#pragma unroll
        for (int ni = 0; ni < 4; ++ni) b[ni] = B_TR ? frag_tr(Bt, TP, kk * 32, cb + ni * 16, lane) : frag_row(Bt, TP, cb + ni * 16, kk * 32, lane);
#pragma unroll
        for (int mi = 0; mi < 2; ++mi)
#pragma unroll
            for (int ni = 0; ni < 4; ++ni) acc[mi][ni] = __builtin_amdgcn_mfma_f32_16x16x32_bf16(a[mi], b[ni], acc[mi][ni], 0, 0, 0);
    }
}
__device__ __forceinline__ void acc_to_stage(const f32x4 (&acc)[2][4], LAS float* st, int wave, int lane) {
    const int rb = (wave >> 1) * 32 + 4 * (lane >> 4), cb = (wave & 1) * 64 + (lane & 15);
#pragma unroll
    for (int mi = 0; mi < 2; ++mi)
#pragma unroll
        for (int ni = 0; ni < 4; ++ni)
#pragma unroll
            for (int r = 0; r < 4; ++r) st[(rb + mi * 16 + r) * SP + cb + ni * 16] = acc[mi][ni][r];
}
__device__ __forceinline__ void tile_g2l(lds_u8* dst, const bf16_t* src, size_t gp, int tid) {
#pragma unroll
    for (int p = 0; p < 4; ++p) { const int row = p * 32 + (tid >> 4), cc = (tid & 15) * 8;
        *(LAS u32x4*)(dst + row * TP + cc * 2) = *(const u32x4*)(src + (size_t)row * gp + cc); }
}

__device__ __forceinline__ void tr_item(const float* src, size_t ldn, bf16_t* dst, size_t dp, float scale, LAS float* scr, int lane) {
    float v[64];
#pragma unroll
    for (int i = 0; i < 64; ++i) v[i] = src[(size_t)i * ldn + lane];
#pragma unroll
    for (int i = 0; i < 64; ++i) scr[i * 65 + lane] = v[i] * scale;
    LDS_WAIT(); asm volatile("" ::: "memory");
    const int c = lane & 7;
#pragma unroll
    for (int j = 0; j < 8; ++j) { const int n = (lane >> 3) + 8 * j; const LAS float* s = scr + (8 * c) * 65 + n;
        u32x4 o; o.x = pk2(s[0 * 65], s[1 * 65]); o.y = pk2(s[2 * 65], s[3 * 65]); o.z = pk2(s[4 * 65], s[5 * 65]); o.w = pk2(s[6 * 65], s[7 * 65]);
        *(u32x4*)(dst + (size_t)n * dp + 8 * c) = o; }
    LDS_WAIT(); asm volatile("" ::: "memory");
}
__device__ __forceinline__ void p0_prologue(Frame& F) {
    PHASE_TID();
    LAS float* scr = (LAS float*)(F.lds + wave * 16640);
    const int gw = F.bid * 8 + wave, NGW = F.G * 8;
    const float* w_in = F.in[3]; const float* w_branch = F.in[16]; const float* w_out = F.in[17]; const float* rgw = F.in[12];
    bf16_t* WIN = (bf16_t*)(F.ws + WS_WIN); bf16_t* WBR = (bf16_t*)(F.ws + WS_WBR); bf16_t* WOUT = (bf16_t*)(F.ws + WS_WOUT); bf16_t* RWT = (bf16_t*)(F.ws + WS_RWT);
    constexpr int I_IN = 64 * 480;
    for (int it = gw; it < DEPTH * I_IN; it += NGW) {
        const int l = it / I_IN, r = it % I_IN, kb = r / 480, nb = r % 480, n0 = nb * 64, ns = n0 + (n0 >= 5120 ? 16 : 0);
        const float sc = (n0 >= C_K && n0 < C_V) ? 0.08838834764831845f : 1.0f;
        tr_item(w_in + ((size_t)l * DM + kb * 64) * PROJ_W + ns, PROJ_W, WIN + ((size_t)l * NP + n0) * DM + kb * 64, DM, sc, scr, lane);
    }
    constexpr int I_BR = 16 * 64;
    for (int it = gw; it < DEPTH * 4 * I_BR; it += NGW) {
        const int lg = it / I_BR, r = it % I_BR, l = lg >> 2, g = lg & 3, kb = r / 64, nb = r % 64;
        tr_item(w_branch + ((size_t)lg * BW + kb * 64) * DM + nb * 64, DM, WBR + ((size_t)l * DM + nb * 64) * DM + g * BW + kb * 64, DM, 1.0f, scr, lane);
    }
    constexpr int I_O = 64 * 64;
    for (int it = gw; it < DEPTH * I_O; it += NGW) {
        const int l = it / I_O, r = it % I_O, kb = r / 64, nb = r % 64;
        tr_item(w_out + ((size_t)l * DM + kb * 64) * DM + nb * 64, DM, WOUT + ((size_t)l * DM + nb * 64) * DM + kb * 64, DM, 1.0f, scr, lane);
    }
    for (int it = gw; it < DEPTH * 8 * 8; it += NGW) {
        const int ln = it >> 3, r = it & 7, kb = r >> 2, nb = r & 3;
        tr_item(rgw + ((size_t)ln * 128 + kb * 64) * 256 + nb * 64, 256, RWT + ((size_t)ln * 256 + nb * 64) * 128 + kb * 64, 128, 1.0f, scr, lane);
    }
    const int gt = F.bid * 512 + tid, NGT = F.G * 512;
    bf16_t* WG = (bf16_t*)(F.ws + WS_WG); bf16_t* GWT = (bf16_t*)(F.ws + WS_GWT); const float* gws = F.in[8];
    for (int i = gt; i < DEPTH * DM * 16; i += NGT) { const int j = i & 15, k = (i >> 4) & (DM - 1), l = i >> 16;
        WG[((size_t)l * 16 + j) * DM + k] = (bf16_t)f2bf(w_in[((size_t)l * DM + k) * PROJ_W + 5120 + j]); }
    for (int i = gt; i < DEPTH * 8 * 128 * 128; i += NGT) { const int s = i & 127, t = (i >> 7) & 127;
        GWT[i] = (bf16_t)f2bf(s <= t ? gws[i] : 0.f); }
}

__device__ __forceinline__ void norm_phase(Frame& F, int l) {
    PHASE_TID();
    const bool has_res = l > 0, has_next = l < DEPTH;
    const float* xprev = (l == 2) ? (const float*)(F.ws + WS_X1) : F.in[0];
    float* xnew = (l == 2) ? F.out : (float*)(F.ws + WS_X1);
    const float* OUT = (const float*)(F.ws + WS_OUT); const float* SS = (const float*)(F.ws + WS_SS);
    bf16_t* H = (bf16_t*)(F.ws + WS_H); float* GATES = (float*)(F.ws + WS_GATES);
    const float* pre_w = F.in[1] + (size_t)(has_next ? l : 0) * DM; const float* post_w = F.in[2] + (size_t)(has_res ? l - 1 : 0) * DM;
    const float* gbias = F.in[4] + (size_t)(has_next ? l : 0) * 16;
    __syncthreads();
    if (has_next) {
        const u32x4* src = (const u32x4*)(F.ws + WS_WG + (size_t)l * 16 * DM * 2);
        for (int i = tid; i < 8192; i += 512) *(LAS u32x4*)(F.lds + i * 16) = src[i];
        __syncthreads();
    }
    const int gw = F.bid * 8 + wave, NGW = F.G * 8;
    for (int row = gw; row < SEQ; row += NGW) {
        f32x4 v[16];
        const f32x4* xp = (const f32x4*)(xprev + (size_t)row * DM) + lane;
#pragma unroll
        for (int j = 0; j < 16; ++j) v[j] = xp[64 * j];
        if (has_res) {
            const float ss = wave_sum(SS[(size_t)row * 64 + lane]);
            const float rstd_o = 1.0f / sqrtf(ss * (1.0f / DM) + EPS);
            const f32x4* op = (const f32x4*)(OUT + (size_t)row * DM) + lane; const f32x4* pw = (const f32x4*)post_w + lane;
            f32x4* xo = (f32x4*)(xnew + (size_t)row * DM) + lane;
#pragma unroll
            for (int j = 0; j < 16; ++j) { v[j] = v[j] + op[64 * j] * rstd_o * pw[64 * j]; xo[64 * j] = v[j]; }
        }
        if (has_next) {
            float s2 = 0.f;
#pragma unroll
            for (int j = 0; j < 16; ++j) s2 += (v[j][0] * v[j][0] + v[j][1] * v[j][1]) + (v[j][2] * v[j][2] + v[j][3] * v[j][3]);
            const float rstd = 1.0f / sqrtf(wave_sum(s2) * (1.0f / DM) + EPS);
            const f32x4* pw = (const f32x4*)pre_w + lane;
            u32x2* ho = (u32x2*)(H + (size_t)row * DM) + lane;
#pragma unroll
            for (int j = 0; j < 16; ++j) { v[j] = v[j] * rstd * pw[64 * j]; u32x2 w; w.x = pk2(v[j][0], v[j][1]); w.y = pk2(v[j][2], v[j][3]); ho[64 * j] = w; }
            float mine = 0.f;
#pragma unroll 4
            for (int g = 0; g < 16; ++g) { float a = 0.f;
#pragma unroll
                for (int j = 0; j < 16; ++j) { const u32x2 w = *(const LAS u32x2*)(F.lds + g * 8192 + (256 * j + 4 * lane) * 2);
                    a += v[j][0] * __uint_as_float(w.x << 16) + v[j][1] * __uint_as_float(w.x & 0xffff0000u) + v[j][2] * __uint_as_float(w.y << 16) + v[j][3] * __uint_as_float(w.y & 0xffff0000u); }
                a = wave_sum(a); mine = (lane == g) ? a : mine; }
            if (lane < 16) GATES[(size_t)row * 16 + lane] = mine + gbias[lane];
        }
    }
    __syncthreads();
}

__device__ __forceinline__ float log_sigmoidf_(float x) { return x >= 0.f ? -log1pf(expf(-x)) : x - log1pf(expf(x)); }

__device__ __forceinline__ void mlstm_c1(Frame& F, int unit) {
    PHASE_TID();
    const int h = unit >> 6, c = unit & 63, t0 = c * LCH;
    const bf16_t* PROJ = (const bf16_t*)(F.ws + WS_PROJ); const float* GATES = (const float*)(F.ws + WS_GATES);
    lds_u8* Vs = F.lds; lds_u8* Ks = F.lds + TILE_B;
    LAS float* sLF = (LAS float*)(F.lds + SCAL_OFF); LAS float* sI = sLF + 128; LAS float* sA = sLF + 256; LAS float* sWS = sLF + 384; LAS float* sX = sLF + 512;
    __syncthreads();
    if (tid < 128) { const float fp = GATES[(size_t)(t0 + tid) * 16 + 8 + h]; sLF[tid] = log_sigmoidf_(fp); sI[tid] = GATES[(size_t)(t0 + tid) * 16 + h]; }
    __syncthreads();
    if (tid == 0) {
        float* TB = (float*)(F.ws + WS_TB) + (size_t)h * SEQ + t0; float* TA = TB + (size_t)8 * SEQ; float* TU = TA + (size_t)8 * SEQ;
        float b = 0.f, u = -3.0e38f;
        for (int t = 0; t < 128; ++t) { b += sLF[t]; const float a = sI[t] - b; u = fmaxf(u, a); sA[t] = a; TB[t] = b; TA[t] = a; TU[t] = u; }
        sX[0] = u; sX[1] = b;
        float* BL = (float*)(F.ws + WS_DN + 256 * 1024); float* ML = BL + 1024;
        BL[h * 64 + c] = b; ML[h * 64 + c] = b + u;
    }
    __syncthreads();
    if (tid < 128) sWS[tid] = expf(sA[tid] - sX[0]);
    __syncthreads();
#pragma unroll
    for (int p = 0; p < 4; ++p) { const int row = p * 32 + (tid >> 4), cc = (tid & 15) * 8; const size_t gro = (size_t)(t0 + row) * NP + h * 128 + cc;
        *(LAS u32x4*)(Vs + row * TP + cc * 2) = *(const u32x4*)(PROJ + gro + C_V);
        float kf[8]; unpack8(*(const u32x4*)(PROJ + gro + C_K), kf); const float w = sWS[row];
#pragma unroll
        for (int j = 0; j < 8; ++j) kf[j] *= w;
        *(LAS u32x4*)(Ks + row * TP + cc * 2) = pack8(kf); }
    __syncthreads();
    f32x4 acc[2][4];
    mm128<true, true>(acc, Vs, Ks, wave, lane);
    float* DC = (float*)(F.ws + WS_DC) + (size_t)unit * 16384;
    { const int rb = (wave >> 1) * 32 + 4 * (lane >> 4), cb = (wave & 1) * 64 + (lane & 15);
#pragma unroll
      for (int mi = 0; mi < 2; ++mi)
#pragma unroll
        for (int ni = 0; ni < 4; ++ni)
#pragma unroll
            for (int r = 0; r < 4; ++r) DC[(rb + mi * 16 + r) * 128 + cb + ni * 16] = acc[mi][ni][r]; }
    if (tid < 128) { float s = 0.f; for (int t = 0; t < 128; ++t) s += bf2f(*(const LAS unsigned short*)(Ks + t * TP + tid * 2));
        ((float*)(F.ws + WS_DN))[(size_t)unit * 128 + tid] = s; }
}

__device__ __forceinline__ void mlstm_c2(Frame& F) {
    const float* DC = (const float*)(F.ws + WS_DC); const float* DN = (const float*)(F.ws + WS_DN);
    const float* BL = (const float*)(F.ws + WS_DN + 256 * 1024); const float* ML = BL + 1024;
    bf16_t* CST = (bf16_t*)(F.ws + WS_CST); float* NST = (float*)(F.ws + WS_NST); float* MST = (float*)(F.ws + WS_NST + 256 * 1024);
    PHASE_TID();
    const int gt = F.bid * 512 + tid, NGT = F.G * 512;
    for (int e = gt; e < 8 * 16384; e += NGT) {
        const int h = e >> 14, idx = e & 16383;
        float m = 0.f, C = 0.f, n = 0.f;
        for (int c = 0; c < NCH; ++c) {
            const size_t u = (size_t)h * 64 + c;
            CST[u * 16384 + idx] = (bf16_t)f2bf(C);
            if (idx < 128) NST[u * 128 + idx] = n;
            if (idx == 0) MST[u] = m;
            const float bl = BL[u], ml = ML[u];
            const float mn = fmaxf(bl + m, ml), dec = expf(bl + m - mn), sc = expf(ml - mn);
            C = dec * C + sc * DC[u * 16384 + idx];
            if (idx < 128) n = dec * n + sc * DN[u * 128 + idx];
            m = mn;
        }
    }
}

__device__ __forceinline__ void mlstm_c3(Frame& F, int unit, int l) {
    PHASE_TID();
    const int h = unit >> 6, c = unit & 63, t0 = c * LCH;
    const bf16_t* PROJ = (const bf16_t*)(F.ws + WS_PROJ);
    lds_u8* Qs = F.lds; lds_u8* Ks = F.lds + TILE_B; lds_u8* Vs = F.lds + 2 * TILE_B; lds_u8* Cs = F.lds + 3 * TILE_B;
    LAS float* sA = (LAS float*)(F.lds + SCAL_OFF); LAS float* sM = sA + 128; LAS float* sWi = sA + 256; LAS float* sEm = sA + 384; LAS float* sN = sA + 512;
    LAS float* sDen = sA + 640;   LAS float* sNq = sA + 896;
    __syncthreads();
    tile_g2l(Qs, PROJ + (size_t)t0 * NP + C_Q + h * 128, NP, tid);
    tile_g2l(Ks, PROJ + (size_t)t0 * NP + C_K + h * 128, NP, tid);
    tile_g2l(Vs, PROJ + (size_t)t0 * NP + C_V + h * 128, NP, tid);
    tile_g2l(Cs, (const bf16_t*)(F.ws + WS_CST) + (size_t)unit * 16384, 128, tid);
    if (tid < 128) {
        const float* TB = (const float*)(F.ws + WS_TB) + (size_t)h * SEQ + t0; const float* TA = TB + (size_t)8 * SEQ; const float* TU = TA + (size_t)8 * SEQ;
        const float mc = ((const float*)(F.ws + WS_NST + 256 * 1024))[unit];
        const float b = TB[tid], a = TA[tid], u = TU[tid], M = fmaxf(mc, u);
        sA[tid] = a; sM[tid] = M; sWi[tid] = expf(mc - M); sEm[tid] = expf(-(b + M));
        sN[tid] = ((const float*)(F.ws + WS_NST))[(size_t)unit * 128 + tid];
    }
    __syncthreads();
    f32x4 accS[2][4];
    mm128<false, false>(accS, Qs, Ks, wave, lane);
    const int rb = (wave >> 1) * 32 + 4 * (lane >> 4), cb = (wave & 1) * 64 + (lane & 15);
    {
#pragma unroll
        for (int mi = 0; mi < 2; ++mi)
#pragma unroll
            for (int r = 0; r < 4; ++r) { const int t = rb + mi * 16 + r; const float Mt = sM[t]; float ds = 0.f;
#pragma unroll
                for (int ni = 0; ni < 4; ++ni) { const int s = cb + ni * 16; const float e = expf(sA[s] - Mt); const float p = (s <= t) ? accS[mi][ni][r] * e : 0.f; accS[mi][ni][r] = p; ds += p; }
                ds += __shfl_xor(ds, 1); ds += __shfl_xor(ds, 2); ds += __shfl_xor(ds, 4); ds += __shfl_xor(ds, 8);
                if ((lane & 15) == 0) sDen[t * 2 + (wave & 1)] = ds; }
    }
    {
        const int t = tid >> 2, q4 = tid & 3; float s = 0.f;
#pragma unroll
        for (int j = 0; j < 4; ++j) { float qf[8]; unpack8(*(const LAS u32x4*)(Qs + t * TP + (q4 * 32 + j * 8) * 2), qf);
#pragma unroll
            for (int i = 0; i < 8; ++i) s += qf[i] * sN[q4 * 32 + j * 8 + i]; }
        s += __shfl_xor(s, 1); s += __shfl_xor(s, 2);
        if (q4 == 0) sNq[t] = s;
    }
    __syncthreads();
#pragma unroll
    for (int mi = 0; mi < 2; ++mi)
#pragma unroll
        for (int ni = 0; ni < 4; ++ni)
#pragma unroll
            for (int r = 0; r < 4; ++r) *(LAS unsigned short*)(Ks + (rb + mi * 16 + r) * TP + (cb + ni * 16) * 2) = (unsigned short)f2bf(accS[mi][ni][r]);
    f32x4 accB[2][4];
    mm128<false, false>(accB, Qs, Cs, wave, lane);
    __syncthreads();
    f32x4 accA[2][4];
    mm128<false, true>(accA, Ks, Vs, wave, lane);
    __syncthreads();
    LAS float* st = (LAS float*)F.lds;
#pragma unroll
    for (int mi = 0; mi < 2; ++mi)
#pragma unroll
        for (int r = 0; r < 4; ++r) { const int t = rb + mi * 16 + r; const float wi = sWi[t];
#pragma unroll
            for (int ni = 0; ni < 4; ++ni) st[t * SP + cb + ni * 16] = accA[mi][ni][r] + wi * accB[mi][ni][r]; }
    __syncthreads();
    const float* nw = F.in[5] + (size_t)l * BW + h * 128; bf16_t* YS = (bf16_t*)(F.ws + WS_YS);
#pragma unroll
    for (int p = 0; p < 4; ++p) { const int t = p * 32 + (tid >> 4), cc = (tid & 15) * 8;
        const float den = sDen[t * 2] + sDen[t * 2 + 1] + sWi[t] * sNq[t];
        const float dn = fmaxf(fabsf(den), sEm[t]); const float inv = 1.0f / dn;
        float hv[8]; float ss = 0.f;
#pragma unroll
        for (int j = 0; j < 8; ++j) { hv[j] = st[t * SP + cc + j] * inv; ss += hv[j] * hv[j]; }
        ss += __shfl_xor(ss, 1); ss += __shfl_xor(ss, 2); ss += __shfl_xor(ss, 4); ss += __shfl_xor(ss, 8);
        const float rinv = 1.0f / sqrtf(ss * (1.0f / 128.0f) + EPS);
        const size_t gro = (size_t)(t0 + t) * NP + h * 128 + cc;
        float so[8], sz[8]; unpack8(*(const u32x4*)(PROJ + gro + C_O), so); unpack8(*(const u32x4*)(PROJ + gro + C_ZA), sz);
        float y[8];
#pragma unroll
        for (int j = 0; j < 8; ++j) y[j] = hv[j] * rinv * nw[cc + j] * so[j] * sz[j];
        *(u32x4*)(YS + (size_t)(t0 + t) * DM + h * 128 + cc) = pack8(y); }
}

__device__ __forceinline__ void gmlp_unit(Frame& F, int unit, int l) {
    PHASE_TID();
    const int c = unit >> 3, g = unit & 7, t0 = c * LCH;
    const bf16_t* PROJ = (const bf16_t*)(F.ws + WS_PROJ);
    lds_u8* Ws = F.lds; lds_u8* Vn = F.lds + TILE_B; LAS float* st = (LAS float*)(F.lds + 2 * TILE_B);
    LAS float* sMean = (LAS float*)(F.lds + SCAL_OFF); LAS float* sRstd = sMean + 128;
    __syncthreads();
    {
        const int row = tid >> 2, q4 = tid & 3; const bf16_t* p = PROJ + (size_t)(t0 + row) * NP + C_VG + q4 * 256; float s = 0.f, s2 = 0.f;
#pragma unroll 8
        for (int j = 0; j < 32; ++j) { float f[8]; unpack8(*(const u32x4*)(p + j * 8), f);
#pragma unroll
            for (int i = 0; i < 8; ++i) { s += f[i]; s2 += f[i] * f[i]; } }
        s += __shfl_xor(s, 1); s += __shfl_xor(s, 2); s2 += __shfl_xor(s2, 1); s2 += __shfl_xor(s2, 2);
        const float mean = s * (1.0f / 1024.0f), var = fmaxf(s2 * (1.0f / 1024.0f) - mean * mean, 0.f);
        if (q4 == 0) { sMean[row] = mean; sRstd[row] = 1.0f / sqrtf(var + EPS); }
    }
    __syncthreads();
    const float* lnw = F.in[6] + (size_t)l * BW + g * 128; const float* lnb = F.in[7] + (size_t)l * BW + g * 128;
    tile_g2l(Ws, (const bf16_t*)(F.ws + WS_GWT) + ((size_t)l * 8 + g) * 16384, 128, tid);
#pragma unroll
    for (int p = 0; p < 4; ++p) { const int row = p * 32 + (tid >> 4), cc = (tid & 15) * 8;
        float f[8]; unpack8(*(const u32x4*)(PROJ + (size_t)(t0 + row) * NP + C_VG + g * 128 + cc), f); const float mean = sMean[row], rstd = sRstd[row];
#pragma unroll
        for (int j = 0; j < 8; ++j) f[j] = (f[j] - mean) * rstd * lnw[cc + j] + lnb[cc + j];
        *(LAS u32x4*)(Vn + row * TP + cc * 2) = pack8(f); }
    __syncthreads();
    f32x4 acc[2][4];
    mm128<false, true>(acc, Ws, Vn, wave, lane);
    acc_to_stage(acc, st, wave, lane);
    __syncthreads();
    const float* bs = F.in[9] + ((size_t)l * 8 + g) * 128; bf16_t* YS = (bf16_t*)(F.ws + WS_YS);
#pragma unroll
    for (int p = 0; p < 4; ++p) { const int t = p * 32 + (tid >> 4), cc = (tid & 15) * 8; const size_t gro = (size_t)(t0 + t) * NP + g * 128 + cc;
        float uf[8], zf[8]; unpack8(*(const u32x4*)(PROJ + gro + C_U), uf); unpack8(*(const u32x4*)(PROJ + gro + C_ZB), zf); const float b = bs[t];
        float y[8];
#pragma unroll
        for (int j = 0; j < 8; ++j) y[j] = uf[j] * (st[t * SP + cc + j] + b) * zf[j];
        *(u32x4*)(YS + (size_t)(t0 + t) * DM + BW + g * 128 + cc) = pack8(y); }
}

__device__ __forceinline__ void rglru_conv8(const bf16_t* PROJ, int tg, int chg, const float* cw, const float* cb, float (&x)[8]) {
#pragma unroll
    for (int j = 0; j < 8; ++j) x[j] = cb[chg + j];
#pragma unroll
    for (int k = 0; k < 4; ++k) { const int ts = tg - 3 + k; if (ts >= 0) { float f[8]; unpack8(*(const u32x4*)(PROJ + (size_t)ts * NP + C_XC + chg), f);
#pragma unroll
        for (int j = 0; j < 8; ++j) x[j] += cw[k * BW + chg + j] * f[j]; } }
}
__device__ __forceinline__ void rglru_c1(Frame& F, int unit, int l) {
    PHASE_TID();
    const int c = unit >> 3, n = unit & 7, t0 = c * LCH;
    const bf16_t* PROJ = (const bf16_t*)(F.ws + WS_PROJ);
    const float* cw = F.in[10] + (size_t)l * 4 * BW; const float* cb = F.in[11] + (size_t)l * BW;
    lds_u8* Xs = F.lds; lds_u8* Wr = F.lds + TILE_B; lds_u8* Wi = F.lds + 2 * TILE_B;
    LAS float* stR = (LAS float*)F.lds; LAS float* stI = (LAS float*)(F.lds + 2 * TILE_B);
    __syncthreads();
#pragma unroll
    for (int p = 0; p < 4; ++p) { const int t = p * 32 + (tid >> 4), cc = (tid & 15) * 8; float x[8]; rglru_conv8(PROJ, t0 + t, n * 128 + cc, cw, cb, x);
        *(LAS u32x4*)(Xs + t * TP + cc * 2) = pack8(x); }
    const bf16_t* RWT = (const bf16_t*)(F.ws + WS_RWT) + ((size_t)l * 8 + n) * 256 * 128;
    tile_g2l(Wr, RWT, 128, tid); tile_g2l(Wi, RWT + 128 * 128, 128, tid);
    __syncthreads();
    f32x4 accR[2][4], accI[2][4];
    mm128<false, false>(accR, Xs, Wr, wave, lane);
    mm128<false, false>(accI, Xs, Wi, wave, lane);
    __syncthreads();
    acc_to_stage(accR, stR, wave, lane); acc_to_stage(accI, stI, wave, lane);
    __syncthreads();
    const float* bgate = F.in[13] + (size_t)l * 2 * BW; const float* ap = F.in[14] + (size_t)l * BW;
#pragma unroll
    for (int p = 0; p < 4; ++p) { const int t = p * 32 + (tid >> 4), cc = (tid & 15) * 8, chg = n * 128 + cc; float x[8]; rglru_conv8(PROJ, t0 + t, chg, cw, cb, x);
#pragma unroll
        for (int j = 0; j < 8; ++j) { const float r = sigmoidf_(stR[t * SP + cc + j] + bgate[chg + j]), ig = sigmoidf_(stI[t * SP + cc + j] + bgate[BW + chg + j]);
            const float av = ap[chg + j]; const float spl = (av > 0.f) ? log1pf(expf(-av)) : (-av + log1pf(expf(av)));
            const float la = -8.0f * r * spl; const float a = expf(la); float mult = sqrtf(fmaxf(-expm1f(2.0f * la), 0.f)); if (t0 + t == 0) mult = 1.0f;
            stR[t * SP + cc + j] = a; stI[t * SP + cc + j] = mult * ig * x[j]; } }
    __syncthreads();
    if (tid < 128) { float hh = 0.f, A = 1.f; float* HL = (float*)(F.ws + WS_HLOC) + (size_t)t0 * BW + n * 128 + tid; float* AC = (float*)(F.ws + WS_ACUM) + (size_t)t0 * BW + n * 128 + tid;
        for (int t = 0; t < 128; ++t) { const float a = stR[t * SP + tid], bx = stI[t * SP + tid]; hh = a * hh + bx; A *= a; HL[(size_t)t * BW] = hh; AC[(size_t)t * BW] = A; }
        float* AP = (float*)(F.ws + WS_APROD); AP[c * BW + n * 128 + tid] = A; AP[65536 + c * BW + n * 128 + tid] = hh; }
}
__device__ __forceinline__ void rglru_c3(Frame& F, int unit) {
    PHASE_TID();
    const int c = unit >> 3, n = unit & 7, t0 = c * LCH;
    const bf16_t* PROJ = (const bf16_t*)(F.ws + WS_PROJ);
    LAS float* sCarry = (LAS float*)(F.lds + SCAL_OFF);
    __syncthreads();
    if (tid < 128) { const float* AP = (const float*)(F.ws + WS_APROD) + n * 128 + tid; float carry = 0.f;
        for (int cp = 0; cp < c; ++cp) carry = AP[cp * BW] * carry + AP[65536 + cp * BW];
        sCarry[tid] = carry; }
    __syncthreads();
    const float* HL = (const float*)(F.ws + WS_HLOC); const float* AC = (const float*)(F.ws + WS_ACUM); bf16_t* YS = (bf16_t*)(F.ws + WS_YS);
#pragma unroll
    for (int p = 0; p < 4; ++p) { const int t = p * 32 + (tid >> 4), cc = (tid & 15) * 8; const size_t o = (size_t)(t0 + t) * BW + n * 128 + cc;
        const f32x4 h0 = *(const f32x4*)(HL + o), h1 = *(const f32x4*)(HL + o + 4), a0 = *(const f32x4*)(AC + o), a1 = *(const f32x4*)(AC + o + 4);
        float zf[8]; unpack8(*(const u32x4*)(PROJ + (size_t)(t0 + t) * NP + C_ZC + n * 128 + cc), zf);
        float y[8];
#pragma unroll
        for (int j = 0; j < 4; ++j) { y[j] = (h0[j] + a0[j] * sCarry[cc + j]) * zf[j]; y[4 + j] = (h1[j] + a1[j] * sCarry[cc + 4 + j]) * zf[4 + j]; }
        *(u32x4*)(YS + (size_t)(t0 + t) * DM + 2 * BW + n * 128 + cc) = pack8(y); }
}
__device__ __forceinline__ void sconv_unit(Frame& F, int unit, int l) {
    PHASE_TID();
    const int c = unit >> 3, n = unit & 7, t0 = c * LCH;
    const bf16_t* PROJ = (const bf16_t*)(F.ws + WS_PROJ); const float* sw = F.in[15] + (size_t)l * 3 * BW; bf16_t* YS = (bf16_t*)(F.ws + WS_YS);
#pragma unroll
    for (int p = 0; p < 4; ++p) { const int t = t0 + p * 32 + (tid >> 4), chg = n * 128 + (tid & 15) * 8;
        float acc[8];
#pragma unroll
        for (int j = 0; j < 8; ++j) acc[j] = 0.f;
#pragma unroll
        for (int k = 0; k < 3; ++k) { const int ts = t - 2 + k; if (ts >= 0) { float cg[8], xd[8]; unpack8(*(const u32x4*)(PROJ + (size_t)ts * NP + C_CG + chg), cg); unpack8(*(const u32x4*)(PROJ + (size_t)ts * NP + C_XD + chg), xd);
#pragma unroll
            for (int j = 0; j < 8; ++j) acc[j] += sw[k * BW + chg + j] * (cg[j] * xd[j]); } }
        float bg[8], zf[8]; unpack8(*(const u32x4*)(PROJ + (size_t)t * NP + C_BG + chg), bg); unpack8(*(const u32x4*)(PROJ + (size_t)t * NP + C_ZD + chg), zf);
        float y[8];
#pragma unroll
        for (int j = 0; j < 8; ++j) y[j] = bg[j] * acc[j] * zf[j];
        *(u32x4*)(YS + (size_t)t * DM + 3 * BW + chg) = pack8(y); }
}

__global__ void __launch_bounds__(512, 2) hybrid_fwd(Args args) {
    extern __shared__ __attribute__((aligned(16))) unsigned char lds_raw[];
    Frame F;
    F.lds = (lds_u8*)lds_raw;
    F.G = gridDim.x; F.bid = blockIdx.x;
#pragma unroll
    for (int i = 0; i < 18; ++i) F.in[i] = args.in[i];
    F.out = args.out; F.ws = args.ws;
    volatile LAS unsigned* MISC = (volatile LAS unsigned*)(F.lds + MISC_OFF);
    if (threadIdx.x < 64) MISC[threadIdx.x] = 0u;
    __syncthreads();
    XcdBarrier bar = xcd_barrier_post((unsigned*)(F.ws + WS_CTL) + CW_BAR, MISC + 8);
#define GRID_BAR() xcd_barrier(bar)

    p0_prologue(F);
    GRID_BAR();
    for (int l = 0; l <= DEPTH; ++l) {
        norm_phase(F, l);
        if (l == DEPTH) break;
        GRID_BAR();
        {
            pg8::Gemm g{(const bf16_t*)(F.ws + WS_H), (const bf16_t*)(F.ws + WS_WIN + (size_t)l * WIN_L), DM, DM, DM};
            pg8::StaticOrder S; S.init(SEQ, NP, F.G, F.bid, 1);
            pg8::EpiProj E{(bf16_t*)(F.ws + WS_PROJ)};
            pg8::gemm_phase<pg8::EpiProj>(F.lds, g, S, E);
        }
        GRID_BAR();
        for (int u = F.bid; u < 512; u += F.G) mlstm_c1(F, u);
        for (int u = F.bid; u < 512; u += F.G) rglru_c1(F, u, l);
        for (int u = F.bid; u < 512; u += F.G) gmlp_unit(F, u, l);
        for (int u = F.bid; u < 512; u += F.G) sconv_unit(F, u, l);
        GRID_BAR();
        mlstm_c2(F);
        GRID_BAR();
        for (int u = F.bid; u < 512; u += F.G) mlstm_c3(F, u, l);
        for (int u = F.bid; u < 512; u += F.G) rglru_c3(F, u);
        GRID_BAR();
        {
            pg8::Gemm g{(const bf16_t*)(F.ws + WS_YS), (const bf16_t*)(F.ws + WS_WBR + (size_t)l * WSQ_L), DM, DM, BW};
            pg8::StaticOrder S; S.init(SEQ, DM, F.G, F.bid, 4);
            pg8::EpiMerge E{(const bf16_t*)(F.ws + WS_PROJ) + C_G, (float*)(F.ws + WS_OUT), (bf16_t*)(F.ws + WS_MERGED)};
            __syncthreads();
            pg8::gemm_phase<pg8::EpiMerge>(F.lds, g, S, E);
        }
        GRID_BAR();
        {
            pg8::Gemm g{(const bf16_t*)(F.ws + WS_MERGED), (const bf16_t*)(F.ws + WS_WOUT + (size_t)l * WSQ_L), DM, DM, DM};
            pg8::StaticOrder S; S.init(SEQ, DM, F.G, F.bid, 1);
            pg8::EpiOut E{(float*)(F.ws + WS_OUT), (float*)(F.ws + WS_SS)};
            pg8::gemm_phase<pg8::EpiOut>(F.lds, g, S, E);
        }
        GRID_BAR();
    }
}

extern "C" void kernel_launch(void* const* d_in, const int* in_sizes, int n_in, void* d_out, int out_size, void* d_ws, size_t ws_size, hipStream_t stream) {
    static int grid = 0;
    if (grid == 0) {
        if (n_in != 18 || in_sizes[0] != SEQ * DM || out_size != SEQ * DM || ws_size < WS_END) {
            fprintf(stderr, "kernel_launch: unexpected problem: n_in %d in0 %d out %d ws %zu (need %zu)\n", n_in, n_in > 0 ? in_sizes[0] : -1, out_size, ws_size, (size_t)WS_END); grid = -1; return; }
        int dev = 0, cus = 0, per_cu = 0;
        if (hipGetDevice(&dev) != hipSuccess || hipDeviceGetAttribute(&cus, hipDeviceAttributeMultiprocessorCount, dev) != hipSuccess) { fprintf(stderr, "kernel_launch: device query failed\n"); grid = -1; return; }
        if (hipFuncSetAttribute((const void*)hybrid_fwd, hipFuncAttributeMaxDynamicSharedMemorySize, LDS_BYTES) != hipSuccess) { fprintf(stderr, "kernel_launch: hipFuncSetAttribute failed\n"); grid = -1; return; }
        if (hipOccupancyMaxActiveBlocksPerMultiprocessor(&per_cu, (const void*)hybrid_fwd, 512, LDS_BYTES) != hipSuccess || per_cu < 1)
            fprintf(stderr, "kernel_launch: note: occupancy query reports %d workgroups per CU\n", per_cu);
        (void)hipGetLastError();
        grid = cus;
    }
    if (grid < 0) return;
    if (hipMemsetAsync((char*)d_ws + WS_CTL, 0, CTL_ZERO_BYTES, stream) != hipSuccess) { fprintf(stderr, "kernel_launch: memset failed\n"); return; }
    Args a{};
    for (int i = 0; i < 18; ++i) a.in[i] = (const float*)d_in[i];
    a.out = (float*)d_out; a.ws = (unsigned char*)d_ws;
    hipLaunchKernelGGL(hybrid_fwd, dim3(grid), dim3(512), LDS_BYTES, stream, a);
    const hipError_t le = hipPeekAtLastError();
    if (le != hipSuccess) fprintf(stderr, "kernel_launch: launch failed: %s\n", hipGetErrorName(le));
}
```

```cpp
#include <hip/hip_runtime.h>
#include <cstdio>
#include <cstdint>

#define LAS __attribute__((address_space(3)))
#define GAS __attribute__((address_space(1)))
typedef unsigned short bf16_t;
typedef short bf16x8 __attribute__((ext_vector_type(8)));
typedef short bf16x4 __attribute__((ext_vector_type(4)));
typedef float f32x4 __attribute__((ext_vector_type(4)));
typedef float f32x2 __attribute__((ext_vector_type(2)));
typedef unsigned u32x4 __attribute__((ext_vector_type(4)));
typedef unsigned u32x2 __attribute__((ext_vector_type(2)));
typedef LAS unsigned char lds_u8;

#ifndef REP_P0
#define REP_P0 1
#endif
#ifndef REP_NORM
#define REP_NORM 1
#endif
#ifndef REP_B
#define REP_B 1
#endif
#ifndef REP_MIX
#define REP_MIX 1
#endif
#ifndef REP_D
#define REP_D 1
#endif
#ifndef REP_E
#define REP_E 1
#endif
constexpr int DM = 4096, SEQ = 8192, DEPTH = 2, BW = 1024, NHEAD = 8, LCH = 128, NCH = 64;
constexpr int PROJ_W = 30736, NP = 30720;
constexpr int C_Q = 0, C_K = 1024, C_V = 2048, C_O = 3072, C_ZA = 4096, C_U = 5120, C_VG = 6144, C_ZB = 7168, C_XC = 8192, C_ZC = 9216,
              C_BG = 10240, C_CG = 11264, C_XD = 12288, C_ZD = 13312, C_G = 14336;
constexpr float EPS = 1e-6f;

constexpr size_t MiB = 1u << 20;
constexpr size_t WS_CTL = 0, CTL_ZERO_BYTES = 1 * MiB;
constexpr size_t WS_WIN = 16 * MiB;
constexpr size_t WIN_L = (size_t)NP * DM * 2;
constexpr size_t WS_WBR = 496 * MiB;
constexpr size_t WS_WOUT = 560 * MiB;
constexpr size_t WSQ_L = (size_t)DM * DM * 2;
constexpr size_t WS_WG = 624 * MiB;
constexpr size_t WS_GWT = 625 * MiB;
constexpr size_t WS_RWT = 626 * MiB;
constexpr size_t WS_H = 640 * MiB;
constexpr size_t WS_PROJ = 704 * MiB;
constexpr size_t WS_YS = 1184 * MiB;
constexpr size_t WS_MERGED = 1248 * MiB;
constexpr size_t WS_OUT = 1312 * MiB;
constexpr size_t WS_X1 = 1440 * MiB;
constexpr size_t WS_SS = 1568 * MiB;
constexpr size_t WS_GATES = 1570 * MiB;
constexpr size_t WS_TB = 1571 * MiB;
constexpr size_t WS_DC = 1576 * MiB;
constexpr size_t WS_DN = 1608 * MiB;
constexpr size_t WS_CST = 1610 * MiB;
constexpr size_t WS_NST = 1626 * MiB;
constexpr size_t WS_HLOC = 1628 * MiB;
constexpr size_t WS_ACUM = 1660 * MiB;
constexpr size_t WS_APROD = 1692 * MiB;
constexpr size_t WS_END = 1696 * MiB;
constexpr int CW_BAR = 4096;

constexpr int LDS_BYTES = 147456;
constexpr int MISC_OFF = LDS_BYTES - 256;
constexpr int TP = 272;
constexpr int TILE_B = 128 * TP;
constexpr int SP = 132;
constexpr int SCAL_OFF = 4 * TILE_B;

__device__ __forceinline__ float bf2f(unsigned short b) { return __uint_as_float(((unsigned)b) << 16); }
__device__ __forceinline__ unsigned f2bf(float f) { unsigned u = __float_as_uint(f); return (u + 0x7fffu + ((u >> 16) & 1u)) >> 16; }
__device__ __forceinline__ unsigned pk2(float lo, float hi) { return f2bf(lo) | (f2bf(hi) << 16); }
__device__ __forceinline__ unsigned cvt_pk_bf16(float lo, float hi) { unsigned r; asm volatile("v_cvt_pk_bf16_f32 %0, %1, %2" : "=v"(r) : "v"(lo), "v"(hi)); return r; }
__device__ __forceinline__ void unpack8(const u32x4 v, float (&f)[8]) {
    f[0] = __uint_as_float(v.x << 16); f[1] = __uint_as_float(v.x & 0xffff0000u); f[2] = __uint_as_float(v.y << 16); f[3] = __uint_as_float(v.y & 0xffff0000u);
    f[4] = __uint_as_float(v.z << 16); f[5] = __uint_as_float(v.z & 0xffff0000u); f[6] = __uint_as_float(v.w << 16); f[7] = __uint_as_float(v.w & 0xffff0000u);
}
__device__ __forceinline__ u32x4 pack8(const float (&f)[8]) { u32x4 w; w.x = pk2(f[0], f[1]); w.y = pk2(f[2], f[3]); w.z = pk2(f[4], f[5]); w.w = pk2(f[6], f[7]); return w; }
__device__ __forceinline__ float wave_sum(float v) {
#pragma unroll
    for (int o = 1; o < 64; o <<= 1) v += __shfl_xor(v, o);
    return v;
}
__device__ __forceinline__ float sigmoidf_(float x) { return __builtin_amdgcn_rcpf(1.0f + __builtin_amdgcn_exp2f(-1.44269504f * x)); }
#define LDS_WAIT() asm volatile("s_waitcnt lgkmcnt(0)" ::: "memory")
#define VM_WAIT() asm volatile("s_waitcnt vmcnt(0)" ::: "memory")

#define XB_TMO      128
#define XB_XCNT(j)  (256  + 64 * (j))
#define XB_XSUB(j)  (1280 + 64 * (j))
#define XB_XGEN(j)  (2304 + 64 * (j))
#define XB_TOP      3328
#define XB_TOPGEN   3392
#define XCD_BAR_WORDS 3456
#define XB_SPIN_CAP (1u << 18)

__device__ __forceinline__ unsigned xb_ld(unsigned* p)              { return __hip_atomic_load(p, __ATOMIC_RELAXED, __HIP_MEMORY_SCOPE_AGENT); }
__device__ __forceinline__ unsigned xb_add(unsigned* p, unsigned v) { return __hip_atomic_fetch_add(p, v, __ATOMIC_RELAXED, __HIP_MEMORY_SCOPE_AGENT); }
__device__ __forceinline__ unsigned xb_xcc_id() { return (unsigned)__builtin_amdgcn_s_getreg((3 << 11) | 20) & 0xFu; }
#define XB_SPIN(cond, bar) do { unsigned _sp = 0; while (cond) { __builtin_amdgcn_s_sleep(1); \
    if ((++_sp & 255u) == 0u) { if (xb_ld(&(bar)[XB_TMO])) break; if (_sp > XB_SPIN_CAP) { atomicAdd(&(bar)[XB_TMO], 1u); break; } } } } while (0)

struct XcdBarrier { unsigned* bar; unsigned x; volatile LAS unsigned* st; };

__device__ __forceinline__ XcdBarrier xcd_barrier_post(unsigned* bar, volatile LAS unsigned* st) {
    XcdBarrier b; b.bar = bar; b.x = xb_xcc_id(); b.st = st;
    if (threadIdx.x == 0) (void)xb_add(&bar[XB_XCNT(b.x)], 1u);
    return b;
}
__device__ __forceinline__ void xcd_barrier_complete(unsigned* bar, unsigned x, unsigned& nloc, unsigned& nx) {
    const unsigned G = gridDim.x * gridDim.y * gridDim.z;
    unsigned sum, cnt, mine, sp = 0u;
    for (;;) {
        sum = 0u; cnt = 0u; mine = 0u;
#pragma unroll
        for (unsigned j = 0; j < 16; ++j) { const unsigned c = xb_ld(&bar[XB_XCNT(j)]); sum += c; cnt += (c > 0u) ? 1u : 0u; mine = (j == x) ? c : mine; }
        if (sum == G) break;
        __builtin_amdgcn_s_sleep(1);
        if ((++sp & 255u) == 0u) { if (xb_ld(&bar[XB_TMO])) break; if (sp > XB_SPIN_CAP) { atomicAdd(&bar[XB_TMO], 1u); break; } }
    }
    nloc = mine > 0u ? mine : 1u; nx = cnt > 0u ? cnt : 1u;
}
__device__ __forceinline__ void xcd_barrier(const XcdBarrier& b) {
    asm volatile("s_waitcnt vmcnt(0)" ::: "memory");
    __syncthreads();
    if (threadIdx.x == 0) {
        unsigned* bar = b.bar;
        __builtin_amdgcn_s_waitcnt(0);
        unsigned nloc = b.st[0], nx = b.st[1];
        if (nloc == 0u) { xcd_barrier_complete(bar, b.x, nloc, nx); b.st[0] = nloc; b.st[1] = nx; }
        const unsigned old = xb_add(&bar[XB_XSUB(b.x)], 1u);
        const unsigned gen = old / nloc;
        if (old + 1u == (gen + 1u) * nloc) {
            __builtin_amdgcn_fence(__ATOMIC_RELEASE, "agent");
            asm volatile("s_waitcnt vmcnt(0)" ::: "memory");
            const unsigned og = xb_add(&bar[XB_TOP], 1u);
            const unsigned tg = og / nx;
            if (og + 1u == (tg + 1u) * nx) xb_add(&bar[XB_TOPGEN], 1u);
            else XB_SPIN(xb_ld(&bar[XB_TOPGEN]) == tg, bar);
            __builtin_amdgcn_fence(__ATOMIC_ACQUIRE, "agent");
            xb_add(&bar[XB_XGEN(b.x)], 1u);
            asm volatile("s_waitcnt vmcnt(0)" ::: "memory");
        } else {
            XB_SPIN(xb_ld(&bar[XB_XGEN(b.x)]) == gen, bar);
            __builtin_amdgcn_fence(__ATOMIC_ACQUIRE, "agent");
            asm volatile("s_waitcnt vmcnt(0)" ::: "memory");
        }
    }
    __syncthreads();
}

namespace pg8 {
constexpr int BM = 256, BK = 64, HALF = 128, HTB = HALF * BK * 2, STAGE_BYTES = 8 * HTB, NXCD = 8, WGM = 8;
__host__ __device__ __forceinline__ int lds_byte(int r, int c) { const int st = (r >> 4) * 2 + (c >> 5), rr = r & 15, cc = c & 31, ob = rr * 64 + cc * 2; return st * 1024 + (ob ^ (((ob >> 9) & 1) << 5)); }
__host__ __device__ __forceinline__ void stage_rc(int b, int& R, int& C) { const int st = b / 1024, sb = b % 1024, swz = sb ^ (((sb >> 9) & 1) << 5); R = (st >> 1) * 16 + swz / 64; C = (st & 1) * 32 + (swz % 64) / 2; }
__host__ __device__ __forceinline__ int perm32(int rho) { const int n = rho >> 4, i = rho & 15; return 8 * (i >> 2) + 4 * n + (i & 3); }

struct Unit { int pm, pn, g; };
struct Gemm { const bf16_t* A; const bf16_t* Bt; int lda, ldb, K; };

struct StaticOrder {
    int nM, nN, nwg, G, c, gdiv;
    __device__ void init(int M, int N, int G_, int c_, int gdiv_) { nM = M / BM; nN = N / BM; nwg = nM * nN; G = G_; c = c_; gdiv = gdiv_; }
    __device__ bool next(int i, Unit& u) const {
        const int ti = i / gdiv; u.g = i - ti * gdiv;
        const long L = (long)ti * G + c; if (L >= nwg) return false;
        int wgid = (int)L; { const int q = nwg / NXCD, r = nwg % NXCD, xcd = wgid % NXCD, off = wgid / NXCD; wgid = (xcd < r ? xcd * (q + 1) : r * (q + 1) + (xcd - r) * q) + off; }
        const int nig = WGM * nN, gid = wgid / nig, fm = gid * WGM, gsz = (nM - fm) < WGM ? (nM - fm) : WGM;
        u.pm = fm + ((wgid % nig) % gsz); u.pn = (wgid % nig) / gsz; return true;
    }
};


struct EpiProj {
    static constexpr bool PERM = true, CHAIN = false;
    bf16_t* O;
    __device__ __forceinline__ void operator()(f32x4 (&acc)[2][2][4][2], const Unit& u, int wr, int wc, int fr, int fq) const {
        const int row0 = u.pm * BM + wr * 64 + fr, col0 = u.pn * BM + wc * 32 + 8 * fq;
        const int seg = u.pn >> 2;
        const int mode = (seg == 3 || seg >= 14) ? 1 : ((seg == 4 || seg == 7 || seg == 9 || seg == 13) ? 2 : 0);
#pragma unroll
        for (int ai = 0; ai < 2; ++ai)
#pragma unroll
            for (int m = 0; m < 4; ++m) { bf16_t* rowp = O + (size_t)(row0 + ai * HALF + m * 16) * NP + col0;
#pragma unroll
                for (int bj = 0; bj < 2; ++bj) { f32x4 v0 = acc[ai][bj][m][0], v1 = acc[ai][bj][m][1];
                    if (mode != 0) {
#pragma unroll
                        for (int j = 0; j < 4; ++j) { const float s0 = sigmoidf_(v0[j]), s1 = sigmoidf_(v1[j]); v0[j] = (mode == 1) ? s0 : v0[j] * s0; v1[j] = (mode == 1) ? s1 : v1[j] * s1; }
                    }
                    u32x4 w; w.x = cvt_pk_bf16(v0[0], v0[1]); w.y = cvt_pk_bf16(v0[2], v0[3]); w.z = cvt_pk_bf16(v1[0], v1[1]); w.w = cvt_pk_bf16(v1[2], v1[3]);
                    *(u32x4*)(rowp + bj * HALF) = w; } }
    }
};
struct EpiMerge {
    static constexpr bool PERM = true, CHAIN = true;
    const bf16_t* G; bf16_t* MERGED;
    __device__ __forceinline__ void operator()(f32x4 (&acc)[2][2][4][2], const Unit& u, int wr, int wc, int fr, int fq) const {
        const int row0 = u.pm * BM + wr * 64 + fr, col0 = u.pn * BM + wc * 32 + 8 * fq;
        const int g = u.g;
#pragma unroll
        for (int ai = 0; ai < 2; ++ai)
#pragma unroll
            for (int m = 0; m < 4; ++m) { const size_t r = (size_t)(row0 + ai * HALF + m * 16);
#pragma unroll
                for (int bj = 0; bj < 2; ++bj) { const int c = col0 + bj * HALF;
                    const u32x4 gw = *(const u32x4*)(G + r * NP + (size_t)g * DM + c);
                    float gf[8]; unpack8(gw, gf);
#pragma unroll
                    for (int j = 0; j < 8; ++j) gf[j] = fmaxf(gf[j], 1e-12f);
                    if (g < 3) { const u32x4 gn = *(const u32x4*)(G + r * NP + (size_t)(g + 1) * DM + c); float nf[8]; unpack8(gn, nf);
#pragma unroll
                        for (int j = 0; j < 8; ++j) gf[j] *= __builtin_amdgcn_rcpf(fmaxf(nf[j], 1e-12f)); }
                    f32x4 v0 = acc[ai][bj][m][0], v1 = acc[ai][bj][m][1];
                    v0[0] *= gf[0]; v0[1] *= gf[1]; v0[2] *= gf[2]; v0[3] *= gf[3]; v1[0] *= gf[4]; v1[1] *= gf[5]; v1[2] *= gf[6]; v1[3] *= gf[7];
                    if (g < 3) { acc[ai][bj][m][0] = v0; acc[ai][bj][m][1] = v1; }
                    else { u32x4 w; w.x = cvt_pk_bf16(v0[0], v0[1]); w.y = cvt_pk_bf16(v0[2], v0[3]); w.z = cvt_pk_bf16(v1[0], v1[1]); w.w = cvt_pk_bf16(v1[2], v1[3]);
                        *(u32x4*)(MERGED + r * DM + c) = w; } }
                asm volatile("" ::: "memory"); }
    }
};
struct EpiOut {
    static constexpr bool PERM = false, CHAIN = false;
    float* OUT; float* SS;
    __device__ __forceinline__ void operator()(f32x4 (&acc)[2][2][4][2], const Unit& u, int wr, int wc, int fr, int fq) const {
        const int row0 = u.pm * BM + wr * 64 + fr, col0 = u.pn * BM + wc * 32 + 4 * fq;
#pragma unroll
        for (int ai = 0; ai < 2; ++ai)
#pragma unroll
            for (int m = 0; m < 4; ++m) { const size_t r = (size_t)(row0 + ai * HALF + m * 16); float* rowp = OUT + r * DM + col0; float q = 0.f;
#pragma unroll
                for (int bj = 0; bj < 2; ++bj)
#pragma unroll
                    for (int n = 0; n < 2; ++n) { const f32x4 v = acc[ai][bj][m][n]; *(f32x4*)(rowp + bj * HALF + n * 16) = v; q += (v[0] * v[0] + v[1] * v[1]) + (v[2] * v[2] + v[3] * v[3]); }
                q += __shfl_xor(q, 16); q += __shfl_xor(q, 32);
                if (fq == 0) SS[r * 64 + u.pn * 4 + wc] = q; }
    }
};

template <class Epi>
__device__ __forceinline__ void gemm_phase(lds_u8* lds, const Gemm g, const StaticOrder& S, const Epi& E) {
    int tid = threadIdx.x; asm volatile("" : "+v"(tid));
    const int wid = __builtin_amdgcn_readfirstlane(tid >> 6), lane = tid & 63, wr = wid >> 2, wc = wid & 3, fr = lane & 15, fq = lane >> 4;
    const int K = g.K, nt = K / BK;
    unsigned voffA[2], voffB[2];
#pragma unroll
    for (int i = 0; i < 2; ++i) { int R, C; stage_rc(tid * 16 + i * 8192, R, C); const int Rb = Epi::PERM ? ((R & ~31) + perm32(R & 31)) : R;
        voffA[i] = (unsigned)(R * g.lda + C) * 2u; voffB[i] = (unsigned)(Rb * g.ldb + C) * 2u; }
    const size_t kstep = (size_t)(BK * 2);
    const size_t hstepA = (size_t)HALF * g.lda * 2, hstepB = (size_t)HALF * g.ldb * 2;
    const size_t tstepA = 2 * hstepA, tstepB = 2 * hstepB;
    const unsigned ldsw = (unsigned)wid * 1024u;
    const int aoff = lds_byte(wr * 64 + fr, fq * 8), boff = lds_byte(wc * 32 + fr, fq * 8);
#define PG8_SA(b, h) (((b) * 2 + (h)) * HTB)
#define PG8_SB(b, h) ((4 + (b) * 2 + (h)) * HTB)
#define PG8_STAGE(bufoff, gbase, voff) do { _Pragma("unroll") for (int _i = 0; _i < 2; ++_i) \
        __builtin_amdgcn_global_load_lds((const unsigned*)((const char*)(gbase) + (voff)[_i]), (LAS unsigned*)(lds + (bufoff) + ldsw + _i * 8192), 16, 0, 0); } while (0)
#define PG8_LDA(dst, b, h) do { _Pragma("unroll") for (int m = 0; m < 4; ++m) _Pragma("unroll") for (int k = 0; k < 2; ++k) dst[m][k] = *(const LAS bf16x8*)(lds + PG8_SA(b, h) + aoff + m * 2048 + k * 1024); } while (0)
#define PG8_LDB(dst, b, h) do { _Pragma("unroll") for (int n = 0; n < 2; ++n) _Pragma("unroll") for (int k = 0; k < 2; ++k) dst[n][k] = *(const LAS bf16x8*)(lds + PG8_SB(b, h) + boff + n * 2048 + k * 1024); } while (0)
#define PG8_MMA(ai, bj, At, Bt) do { __builtin_amdgcn_s_setprio(1); _Pragma("unroll") for (int m = 0; m < 4; ++m) _Pragma("unroll") for (int n = 0; n < 2; ++n) _Pragma("unroll") for (int k = 0; k < 2; ++k) \
        acc[ai][bj][m][n] = __builtin_amdgcn_mfma_f32_16x16x32_bf16(Bt[n][k], At[m][k], acc[ai][bj][m][n], 0, 0, 0); __builtin_amdgcn_s_setprio(0); } while (0)
#define PG8_WAIT_V(n) asm volatile("s_waitcnt vmcnt(" #n ")" ::: "memory")
#define PG8_WAIT_L(n) asm volatile("s_waitcnt lgkmcnt(" #n ")" ::: "memory")
#define PG8_BAR __builtin_amdgcn_s_barrier()
#define PG8_SCHED __builtin_amdgcn_sched_barrier(0)
    Unit cur, nxt; int ui = 0;
    if (!S.next(0, cur)) return;
    f32x4 acc[2][2][4][2];
#pragma unroll
    for (int a = 0; a < 2; ++a)
#pragma unroll
        for (int b = 0; b < 2; ++b)
#pragma unroll
            for (int m = 0; m < 4; ++m)
#pragma unroll
                for (int n = 0; n < 2; ++n) acc[a][b][m][n] = (f32x4){0.f, 0.f, 0.f, 0.f};
    bf16x8 At[4][2], B0[2][2], B1[2][2];
    const char* cA = (const char*)g.A + (size_t)cur.pm * tstepA + (size_t)cur.g * K * 2; const char* cB = (const char*)g.Bt + (size_t)cur.pn * tstepB + (size_t)cur.g * K * 2;
    PG8_STAGE(PG8_SB(0, 0), cB, voffB); PG8_STAGE(PG8_SB(0, 1), cB + hstepB, voffB); PG8_STAGE(PG8_SA(0, 0), cA, voffA); PG8_STAGE(PG8_SA(0, 1), cA + hstepA, voffA);
    if (wr == 1) PG8_BAR;
    PG8_WAIT_V(2); PG8_BAR;
    PG8_STAGE(PG8_SB(1, 0), cB + kstep, voffB); PG8_STAGE(PG8_SA(1, 0), cA + kstep, voffA); PG8_STAGE(PG8_SB(1, 1), cB + hstepB + kstep, voffB);
    PG8_WAIT_V(6); PG8_BAR;
    for (;;) {
        const bool has_next = S.next(ui + 1, nxt);
        const char* nA = has_next ? (const char*)g.A + (size_t)nxt.pm * tstepA + (size_t)nxt.g * K * 2 : cA; const char* nB = has_next ? (const char*)g.Bt + (size_t)nxt.pn * tstepB + (size_t)nxt.g * K * 2 : cB;
        for (int t = 0; t < nt; t += 2) {
            const bool last = (t == nt - 2);
            const char* a1 = cA + (size_t)(t + 1) * kstep;
            const char* a2 = last ? nA : cA + (size_t)(t + 2) * kstep; const char* b2 = last ? nB : cB + (size_t)(t + 2) * kstep;
            const char* a3 = a2 + kstep; const char* b3 = b2 + kstep;
            PG8_LDB(B0, 0, 0); PG8_LDB(B1, 0, 1); PG8_SCHED; PG8_LDA(At, 0, 0); PG8_STAGE(PG8_SA(1, 1), a1 + hstepA, voffA);
            PG8_WAIT_V(8); PG8_WAIT_L(0); PG8_BAR; PG8_MMA(0, 0, At, B0); PG8_MMA(0, 1, At, B1); PG8_BAR; PG8_SCHED;
            PG8_LDA(At, 0, 1); PG8_STAGE(PG8_SB(0, 0), b2, voffB); PG8_STAGE(PG8_SB(0, 1), b2 + hstepB, voffB); PG8_STAGE(PG8_SA(0, 0), a2, voffA);
            PG8_WAIT_V(8); PG8_WAIT_L(0); PG8_BAR; PG8_MMA(1, 0, At, B0); PG8_MMA(1, 1, At, B1); PG8_BAR; PG8_SCHED;
            PG8_LDB(B0, 1, 0); PG8_LDB(B1, 1, 1); PG8_SCHED; PG8_LDA(At, 1, 0); PG8_STAGE(PG8_SA(0, 1), a2 + hstepA, voffA);
            PG8_WAIT_V(8); PG8_WAIT_L(0); PG8_BAR; PG8_MMA(0, 0, At, B0); PG8_MMA(0, 1, At, B1); PG8_BAR; PG8_SCHED;
            PG8_LDA(At, 1, 1); PG8_STAGE(PG8_SB(1, 0), b3, voffB); PG8_STAGE(PG8_SB(1, 1), b3 + hstepB, voffB); PG8_STAGE(PG8_SA(1, 0), a3, voffA);
            PG8_WAIT_V(8); PG8_WAIT_L(0); PG8_BAR; PG8_MMA(1, 0, At, B0); PG8_MMA(1, 1, At, B1); PG8_BAR; PG8_SCHED;
        }
        if (wr == 0) PG8_BAR;
        E(acc, cur, wr, wc, fr, fq);
        if (!has_next) break;
        if (!Epi::CHAIN || nxt.g == 0) {
#pragma unroll
        for (int a = 0; a < 2; ++a)
#pragma unroll
            for (int b = 0; b < 2; ++b)
#pragma unroll
                for (int m = 0; m < 4; ++m)
#pragma unroll
                    for (int n = 0; n < 2; ++n) acc[a][b][m][n] = (f32x4){0.f, 0.f, 0.f, 0.f};
        }
        cur = nxt; cA = nA; cB = nB; ++ui;
        if (wr == 1) PG8_BAR;
    }
    PG8_WAIT_V(0);
    PG8_BAR;
#undef PG8_SA
#undef PG8_SB
#undef PG8_STAGE
#undef PG8_LDA
#undef PG8_LDB
#undef PG8_MMA
#undef PG8_WAIT_V
#undef PG8_WAIT_L
#undef PG8_BAR
#undef PG8_SCHED
}
}

struct Frame {
    lds_u8* lds;
    int G, bid;
    const float* in[18];
    float* out;
    unsigned char* ws;
};
struct Args { const float* in[18]; float* out; unsigned char* ws; };

#define PHASE_TID() int tid = threadIdx.x; asm volatile("" : "+v"(tid)); const int lane = tid & 63; const int wave = __builtin_amdgcn_readfirstlane(tid >> 6); (void)lane; (void)wave
__device__ __forceinline__ bf16x8 frag_row(const lds_u8* tile, int pitch, int r0, int k0, int lane) {
    return *(const LAS bf16x8*)(tile + (r0 + (lane & 15)) * pitch + (k0 + (lane >> 4) * 8) * 2);
}
#ifndef TR_NAIVE
#define TR_NAIVE 0
#endif
__device__ __forceinline__ bf16x8 frag_tr(const lds_u8* tile, int pitch, int k0, int n0, int lane) {
#if TR_NAIVE
    bf16x8 f;
#pragma unroll
    for (int j = 0; j < 8; ++j) f[j] = *(const LAS short*)(tile + (k0 + 8 * (lane >> 4) + j) * pitch + (n0 + (lane & 15)) * 2);
    return f;
#else
    const int g = lane >> 4, i = lane & 15, q = i >> 2, p = i & 3;
    const lds_u8* a = tile + (k0 + 8 * g + q) * pitch + (n0 + 4 * p) * 2;
    const bf16x4 lo = __builtin_amdgcn_ds_read_tr16_b64_v4i16((LAS bf16x4*)a);
    const bf16x4 hi = __builtin_amdgcn_ds_read_tr16_b64_v4i16((LAS bf16x4*)(a + 4 * pitch));
    bf16x8 f; f[0] = lo[0]; f[1] = lo[1]; f[2] = lo[2]; f[3] = lo[3]; f[4] = hi[0]; f[5] = hi[1]; f[6] = hi[2]; f[7] = hi[3];
    return f;
#endif
}
template <bool A_TR, bool B_TR>
__device__ __forceinline__ void mm128(f32x4 (&acc)[2][4], const lds_u8* At, const lds_u8* Bt, int wave, int lane) {
    const int rb = (wave >> 1) * 32, cb = (wave & 1) * 64;
#pragma unroll
    for (int mi = 0; mi < 2; ++mi)
#pragma unroll
        for (int ni = 0; ni < 4; ++ni) acc[mi][ni] = (f32x4){0.f, 0.f, 0.f, 0.f};
#pragma unroll
    for (int kk = 0; kk < 4; ++kk) {
        bf16x8 a[2], b[4];
#pragma unroll
        for (int mi = 0; mi < 2; ++mi) a[mi] = A_TR ? frag_tr(At, TP, kk * 32, rb + mi * 16, lane) : frag_row(At, TP, rb + mi * 16, kk * 32, lane);
#pragma unroll
        for (int ni = 0; ni < 4; ++ni) b[ni] = B_TR ? frag_tr(Bt, TP, kk * 32, cb + ni * 16, lane) : frag_row(Bt, TP, cb + ni * 16, kk * 32, lane);
#pragma unroll
        for (int mi = 0; mi < 2; ++mi)
#pragma unroll
            for (int ni = 0; ni < 4; ++ni) acc[mi][ni] = __builtin_amdgcn_mfma_f32_16x16x32_bf16(a[mi], b[ni], acc[mi][ni], 0, 0, 0);
    }
}
__device__ __forceinline__ void acc_to_stage(const f32x4 (&acc)[2][4], LAS float* st, int wave, int lane) {
    const int rb = (wave >> 1) * 32 + 4 * (lane >> 4), cb = (wave & 1) * 64 + (lane & 15);
#pragma unroll
    for (int mi = 0; mi < 2; ++mi)
#pragma unroll
        for (int ni = 0; ni < 4; ++ni)
#pragma unroll
            for (int r = 0; r < 4; ++r) st[(rb + mi * 16 + r) * SP + cb + ni * 16] = acc[mi][ni][r];
}
__device__ __forceinline__ void tile_g2l(lds_u8* dst, const bf16_t* src, size_t gp, int tid) {
#pragma unroll
    for (int p = 0; p < 4; ++p) { const int row = p * 32 + (tid >> 4), cc = (tid & 15) * 8;
        *(LAS u32x4*)(dst + row * TP + cc * 2) = *(const u32x4*)(src + (size_t)row * gp + cc); }
}

__device__ __forceinline__ void tr_item(const float* src, size_t ldn, bf16_t* dst, size_t dp, float scale, LAS float* scr, int lane) {
    float v[64];
#pragma unroll
    for (int i = 0; i < 64; ++i) v[i] = src[(size_t)i * ldn + lane];
#pragma unroll
    for (int i = 0; i < 64; ++i) scr[i * 65 + lane] = v[i] * scale;
    LDS_WAIT(); asm volatile("" ::: "memory");
    const int c = lane & 7;
#pragma unroll
    for (int j = 0; j < 8; ++j) { const int n = (lane >> 3) + 8 * j; const LAS float* s = scr + (8 * c) * 65 + n;
        u32x4 o; o.x = pk2(s[0 * 65], s[1 * 65]); o.y = pk2(s[2 * 65], s[3 * 65]); o.z = pk2(s[4 * 65], s[5 * 65]); o.w = pk2(s[6 * 65], s[7 * 65]);
        *(u32x4*)(dst + (size_t)n * dp + 8 * c) = o; }
    LDS_WAIT(); asm volatile("" ::: "memory");
}
__device__ __forceinline__ void p0_prologue(Frame& F) {
    PHASE_TID();
    LAS float* scr = (LAS float*)(F.lds + wave * 16640);
    const int gw = F.bid * 8 + wave, NGW = F.G * 8;
    const float* w_in = F.in[3]; const float* w_branch = F.in[16]; const float* w_out = F.in[17]; const float* rgw = F.in[12];
    bf16_t* WIN = (bf16_t*)(F.ws + WS_WIN); bf16_t* WBR = (bf16_t*)(F.ws + WS_WBR); bf16_t* WOUT = (bf16_t*)(F.ws + WS_WOUT); bf16_t* RWT = (bf16_t*)(F.ws + WS_RWT);
    constexpr int I_IN = 64 * 480;
    for (int it = gw; it < DEPTH * I_IN; it += NGW) {
        const int l = it / I_IN, r = it % I_IN, kb = r / 480, nb = r % 480, n0 = nb * 64, ns = n0 + (n0 >= 5120 ? 16 : 0);
        const float sc = (n0 >= C_K && n0 < C_V) ? 0.08838834764831845f : 1.0f;
        tr_item(w_in + ((size_t)l * DM + kb * 64) * PROJ_W + ns, PROJ_W, WIN + ((size_t)l * NP + n0) * DM + kb * 64, DM, sc, scr, lane);
    }
    constexpr int I_BR = 16 * 64;
    for (int it = gw; it < DEPTH * 4 * I_BR; it += NGW) {
        const int lg = it / I_BR, r = it % I_BR, l = lg >> 2, g = lg & 3, kb = r / 64, nb = r % 64;
        tr_item(w_branch + ((size_t)lg * BW + kb * 64) * DM + nb * 64, DM, WBR + ((size_t)l * DM + nb * 64) * DM + g * BW + kb * 64, DM, 1.0f, scr, lane);
    }
    constexpr int I_O = 64 * 64;
    for (int it = gw; it < DEPTH * I_O; it += NGW) {
        const int l = it / I_O, r = it % I_O, kb = r / 64, nb = r % 64;
        tr_item(w_out + ((size_t)l * DM + kb * 64) * DM + nb * 64, DM, WOUT + ((size_t)l * DM + nb * 64) * DM + kb * 64, DM, 1.0f, scr, lane);
    }
    for (int it = gw; it < DEPTH * 8 * 8; it += NGW) {
        const int ln = it >> 3, r = it & 7, kb = r >> 2, nb = r & 3;
        tr_item(rgw + ((size_t)ln * 128 + kb * 64) * 256 + nb * 64, 256, RWT + ((size_t)ln * 256 + nb * 64) * 128 + kb * 64, 128, 1.0f, scr, lane);
    }
    const int gt = F.bid * 512 + tid, NGT = F.G * 512;
    bf16_t* WG = (bf16_t*)(F.ws + WS_WG); bf16_t* GWT = (bf16_t*)(F.ws + WS_GWT); const float* gws = F.in[8];
    for (int i = gt; i < DEPTH * DM * 16; i += NGT) { const int j = i & 15, k = (i >> 4) & (DM - 1), l = i >> 16;
        WG[((size_t)l * 16 + j) * DM + k] = (bf16_t)f2bf(w_in[((size_t)l * DM + k) * PROJ_W + 5120 + j]); }
    for (int i = gt; i < DEPTH * 8 * 128 * 128; i += NGT) { const int s = i & 127, t = (i >> 7) & 127;
        GWT[i] = (bf16_t)f2bf(s <= t ? gws[i] : 0.f); }
}

__device__ __forceinline__ void norm_phase(Frame& F, int l) {
    PHASE_TID();
    const bool has_res = l > 0, has_next = l < DEPTH;
    const float* xprev = (l == 2) ? (const float*)(F.ws + WS_X1) : F.in[0];
    float* xnew = (l == 2) ? F.out : (float*)(F.ws + WS_X1);
    const float* OUT = (const float*)(F.ws + WS_OUT); const float* SS = (const float*)(F.ws + WS_SS);
    bf16_t* H = (bf16_t*)(F.ws + WS_H); float* GATES = (float*)(F.ws + WS_GATES);
    const float* pre_w = F.in[1] + (size_t)(has_next ? l : 0) * DM; const float* post_w = F.in[2] + (size_t)(has_res ? l - 1 : 0) * DM;
    const float* gbias = F.in[4] + (size_t)(has_next ? l : 0) * 16;
    __syncthreads();
    if (has_next) {
        const u32x4* src = (const u32x4*)(F.ws + WS_WG + (size_t)l * 16 * DM * 2);
        for (int i = tid; i < 8192; i += 512) *(LAS u32x4*)(F.lds + i * 16) = src[i];
        __syncthreads();
    }
    const int gw = F.bid * 8 + wave, NGW = F.G * 8;
    for (int row = gw; row < SEQ; row += NGW) {
        f32x4 v[16];
        const f32x4* xp = (const f32x4*)(xprev + (size_t)row * DM) + lane;
#pragma unroll
        for (int j = 0; j < 16; ++j) v[j] = xp[64 * j];
        if (has_res) {
            const float ss = wave_sum(SS[(size_t)row * 64 + lane]);
            const float rstd_o = 1.0f / sqrtf(ss * (1.0f / DM) + EPS);
            const f32x4* op = (const f32x4*)(OUT + (size_t)row * DM) + lane; const f32x4* pw = (const f32x4*)post_w + lane;
            f32x4* xo = (f32x4*)(xnew + (size_t)row * DM) + lane;
#pragma unroll
            for (int j = 0; j < 16; ++j) { v[j] = v[j] + op[64 * j] * rstd_o * pw[64 * j]; xo[64 * j] = v[j]; }
        }
        if (has_next) {
            float s2 = 0.f;
#pragma unroll
            for (int j = 0; j < 16; ++j) s2 += (v[j][0] * v[j][0] + v[j][1] * v[j][1]) + (v[j][2] * v[j][2] + v[j][3] * v[j][3]);
            const float rstd = 1.0f / sqrtf(wave_sum(s2) * (1.0f / DM) + EPS);
            const f32x4* pw = (const f32x4*)pre_w + lane;
            u32x2* ho = (u32x2*)(H + (size_t)row * DM) + lane;
#pragma unroll
            for (int j = 0; j < 16; ++j) { v[j] = v[j] * rstd * pw[64 * j]; u32x2 w; w.x = pk2(v[j][0], v[j][1]); w.y = pk2(v[j][2], v[j][3]); ho[64 * j] = w; }
            float mine = 0.f;
#pragma unroll 4
            for (int g = 0; g < 16; ++g) { float a = 0.f;
#pragma unroll
                for (int j = 0; j < 16; ++j) { const u32x2 w = *(const LAS u32x2*)(F.lds + g * 8192 + (256 * j + 4 * lane) * 2);
                    a += v[j][0] * __uint_as_float(w.x << 16) + v[j][1] * __uint_as_float(w.x & 0xffff0000u) + v[j][2] * __uint_as_float(w.y << 16) + v[j][3] * __uint_as_float(w.y & 0xffff0000u); }
                a = wave_sum(a); mine = (lane == g) ? a : mine; }
            if (lane < 16) GATES[(size_t)row * 16 + lane] = mine + gbias[lane];
        }
    }
    __syncthreads();
}

__device__ __forceinline__ float log_sigmoidf_(float x) { return x >= 0.f ? -log1pf(expf(-x)) : x - log1pf(expf(x)); }

__device__ __forceinline__ void mlstm_c1(Frame& F, int unit) {
    PHASE_TID();
    const int h = unit >> 6, c = unit & 63, t0 = c * LCH;
    const bf16_t* PROJ = (const bf16_t*)(F.ws + WS_PROJ); const float* GATES = (const float*)(F.ws + WS_GATES);
    lds_u8* Vs = F.lds; lds_u8* Ks = F.lds + TILE_B;
    LAS float* sA = (LAS float*)(F.lds + SCAL_OFF); LAS float* sX = sA + 128; LAS float* sP = sA + 256;
    __syncthreads();
    if (wave == 0) {
        const int t = 2 * lane;
        const float lf0 = log_sigmoidf_(GATES[(size_t)(t0 + t) * 16 + 8 + h]), lf1 = log_sigmoidf_(GATES[(size_t)(t0 + t + 1) * 16 + 8 + h]);
        const float i0 = GATES[(size_t)(t0 + t) * 16 + h], i1 = GATES[(size_t)(t0 + t + 1) * 16 + h];
        float sc = lf0 + lf1;
#pragma unroll
        for (int d = 1; d < 64; d <<= 1) { const float o = __shfl_up(sc, d); if (lane >= d) sc += o; }
        const float b1 = sc, b0 = sc - lf1, a0 = i0 - b0, a1 = i1 - b1;
        float mx = fmaxf(a0, a1);
#pragma unroll
        for (int d = 1; d < 64; d <<= 1) { const float o = __shfl_up(mx, d); if (lane >= d) mx = fmaxf(mx, o); }
        float mprev = __shfl_up(mx, 1); if (lane == 0) mprev = -3.0e38f;
        const float u0 = fmaxf(mprev, a0), u1 = mx;
        float* TB = (float*)(F.ws + WS_TB) + (size_t)h * SEQ + t0; float* TA = TB + (size_t)8 * SEQ; float* TU = TA + (size_t)8 * SEQ;
        *(f32x2*)(TB + t) = (f32x2){b0, b1}; *(f32x2*)(TA + t) = (f32x2){a0, a1}; *(f32x2*)(TU + t) = (f32x2){u0, u1};
        sA[t] = a0; sA[t + 1] = a1;
        if (lane == 63) { sX[0] = u1; float* BL = (float*)(F.ws + WS_DN + 256 * 1024); float* ML = BL + 1024; BL[h * 64 + c] = b1; ML[h * 64 + c] = b1 + u1; }
    }
    __syncthreads();
    const float umax = sX[0];
#pragma unroll
    for (int p = 0; p < 4; ++p) { const int row = p * 32 + (tid >> 4), cc = (tid & 15) * 8; const size_t gro = (size_t)(t0 + row) * NP + h * 128 + cc;
        *(LAS u32x4*)(Vs + row * TP + cc * 2) = *(const u32x4*)(PROJ + gro + C_V);
        float kf[8]; unpack8(*(const u32x4*)(PROJ + gro + C_K), kf); const float w = __expf(sA[row] - umax);
#pragma unroll
        for (int j = 0; j < 8; ++j) kf[j] *= w;
        *(LAS u32x4*)(Ks + row * TP + cc * 2) = pack8(kf); }
    __syncthreads();
    f32x4 acc[2][4];
    mm128<true, true>(acc, Vs, Ks, wave, lane);
    float* DC = (float*)(F.ws + WS_DC) + (size_t)unit * 16384;
    { const int rb = (wave >> 1) * 32 + 4 * (lane >> 4), cb = (wave & 1) * 64 + (lane & 15);
#pragma unroll
      for (int mi = 0; mi < 2; ++mi)
#pragma unroll
        for (int ni = 0; ni < 4; ++ni)
#pragma unroll
            for (int r = 0; r < 4; ++r) DC[(rb + mi * 16 + r) * 128 + cb + ni * 16] = acc[mi][ni][r]; }
    { const int d = tid & 127, sg = tid >> 7; float sum = 0.f;
#pragma unroll 8
      for (int t = 0; t < 32; ++t) sum += bf2f(*(const LAS unsigned short*)(Ks + (sg * 32 + t) * TP + d * 2));
      sP[sg * 128 + d] = sum; }
    __syncthreads();
    if (tid < 128) ((float*)(F.ws + WS_DN))[(size_t)unit * 128 + tid] = (sP[tid] + sP[128 + tid]) + (sP[256 + tid] + sP[384 + tid]);
}

__device__ __forceinline__ void mlstm_c2(Frame& F) {
    const float* DC = (const float*)(F.ws + WS_DC); const float* DN = (const float*)(F.ws + WS_DN);
    const float* BL = (const float*)(F.ws + WS_DN + 256 * 1024); const float* ML = BL + 1024;
    bf16_t* CST = (bf16_t*)(F.ws + WS_CST); float* NST = (float*)(F.ws + WS_NST); float* MST = (float*)(F.ws + WS_NST + 256 * 1024);
    PHASE_TID();
    const int gt = F.bid * 512 + tid, NGT = F.G * 512;
    for (int e = gt; e < 8 * 16384; e += NGT) {
        const int h = e >> 14, idx = e & 16383;
        float m = 0.f, C = 0.f, n = 0.f;
        for (int c0 = 0; c0 < NCH; c0 += 8) {
            float dc[8], dn[8];
#pragma unroll
            for (int j = 0; j < 8; ++j) { const size_t u = (size_t)h * 64 + c0 + j; dc[j] = DC[u * 16384 + idx]; dn[j] = (idx < 128) ? DN[u * 128 + idx] : 0.f; }
#pragma unroll
            for (int j = 0; j < 8; ++j) { const size_t u = (size_t)h * 64 + c0 + j;
                CST[u * 16384 + idx] = (bf16_t)f2bf(C);
                if (idx < 128) NST[u * 128 + idx] = n;
                if (idx == 0) MST[u] = m;
                const float bl = BL[u], ml = ML[u];
                const float mn = fmaxf(bl + m, ml), dec = __expf(bl + m - mn), sc = __expf(ml - mn);
                C = dec * C + sc * dc[j]; n = dec * n + sc * dn[j]; m = mn; }
        }
    }
}

__device__ __forceinline__ void mlstm_c3(Frame& F, int unit, int l) {
    PHASE_TID();
    const int h = unit >> 6, c = unit & 63, t0 = c * LCH;
    const bf16_t* PROJ = (const bf16_t*)(F.ws + WS_PROJ);
    lds_u8* Qs = F.lds; lds_u8* Ks = F.lds + TILE_B; lds_u8* Vs = F.lds + 2 * TILE_B; lds_u8* Cs = F.lds + 3 * TILE_B;
    LAS float* sA = (LAS float*)(F.lds + SCAL_OFF); LAS float* sM = sA + 128; LAS float* sWi = sA + 256; LAS float* sEm = sA + 384; LAS float* sN = sA + 512;
    LAS float* sDen = sA + 640;   LAS float* sNq = sA + 896;
    __syncthreads();
    tile_g2l(Qs, PROJ + (size_t)t0 * NP + C_Q + h * 128, NP, tid);
    tile_g2l(Ks, PROJ + (size_t)t0 * NP + C_K + h * 128, NP, tid);
    tile_g2l(Vs, PROJ + (size_t)t0 * NP + C_V + h * 128, NP, tid);
    tile_g2l(Cs, (const bf16_t*)(F.ws + WS_CST) + (size_t)unit * 16384, 128, tid);
    if (tid < 128) {
        const float* TB = (const float*)(F.ws + WS_TB) + (size_t)h * SEQ + t0; const float* TA = TB + (size_t)8 * SEQ; const float* TU = TA + (size_t)8 * SEQ;
        const float mc = ((const float*)(F.ws + WS_NST + 256 * 1024))[unit];
        const float b = TB[tid], a = TA[tid], u = TU[tid], M = fmaxf(mc, u);
        sA[tid] = a; sM[tid] = M; sWi[tid] = expf(mc - M); sEm[tid] = expf(-(b + M));
        sN[tid] = ((const float*)(F.ws + WS_NST))[(size_t)unit * 128 + tid];
    }
    __syncthreads();
    f32x4 accS[2][4];
    mm128<false, false>(accS, Qs, Ks, wave, lane);
    const int rb = (wave >> 1) * 32 + 4 * (lane >> 4), cb = (wave & 1) * 64 + (lane & 15);
    {
#pragma unroll
        for (int mi = 0; mi < 2; ++mi)
#pragma unroll
            for (int r = 0; r < 4; ++r) { const int t = rb + mi * 16 + r; const float Mt = sM[t]; float ds = 0.f;
#pragma unroll
                for (int ni = 0; ni < 4; ++ni) { const int s = cb + ni * 16; const float e = expf(sA[s] - Mt); const float p = (s <= t) ? accS[mi][ni][r] * e : 0.f; accS[mi][ni][r] = p; ds += p; }
                ds += __shfl_xor(ds, 1); ds += __shfl_xor(ds, 2); ds += __shfl_xor(ds, 4); ds += __shfl_xor(ds, 8);
                if ((lane & 15) == 0) sDen[t * 2 + (wave & 1)] = ds; }
    }
    {
        const int t = tid >> 2, q4 = tid & 3; float s = 0.f;
#pragma unroll
        for (int j = 0; j < 4; ++j) { float qf[8]; unpack8(*(const LAS u32x4*)(Qs + t * TP + (q4 * 32 + j * 8) * 2), qf);
#pragma unroll
            for (int i = 0; i < 8; ++i) s += qf[i] * sN[q4 * 32 + j * 8 + i]; }
        s += __shfl_xor(s, 1); s += __shfl_xor(s, 2);
        if (q4 == 0) sNq[t] = s;
    }
    __syncthreads();
#pragma unroll
    for (int mi = 0; mi < 2; ++mi)
#pragma unroll
        for (int ni = 0; ni < 4; ++ni)
#pragma unroll
            for (int r = 0; r < 4; ++r) *(LAS unsigned short*)(Ks + (rb + mi * 16 + r) * TP + (cb + ni * 16) * 2) = (unsigned short)f2bf(accS[mi][ni][r]);
    f32x4 accB[2][4];
    mm128<false, false>(accB, Qs, Cs, wave, lane);
    __syncthreads();
    f32x4 accA[2][4];
    mm128<false, true>(accA, Ks, Vs, wave, lane);
    __syncthreads();
    LAS float* st = (LAS float*)F.lds;
#pragma unroll
    for (int mi = 0; mi < 2; ++mi)
#pragma unroll
        for (int r = 0; r < 4; ++r) { const int t = rb + mi * 16 + r; const float wi = sWi[t];
#pragma unroll
            for (int ni = 0; ni < 4; ++ni) st[t * SP + cb + ni * 16] = accA[mi][ni][r] + wi * accB[mi][ni][r]; }
    __syncthreads();
    const float* nw = F.in[5] + (size_t)l * BW + h * 128; bf16_t* YS = (bf16_t*)(F.ws + WS_YS);
#pragma unroll
    for (int p = 0; p < 4; ++p) { const int t = p * 32 + (tid >> 4), cc = (tid & 15) * 8;
        const float den = sDen[t * 2] + sDen[t * 2 + 1] + sWi[t] * sNq[t];
        const float dn = fmaxf(fabsf(den), sEm[t]); const float inv = 1.0f / dn;
        float hv[8]; float ss = 0.f;
#pragma unroll
        for (int j = 0; j < 8; ++j) { hv[j] = st[t * SP + cc + j] * inv; ss += hv[j] * hv[j]; }
        ss += __shfl_xor(ss, 1); ss += __shfl_xor(ss, 2); ss += __shfl_xor(ss, 4); ss += __shfl_xor(ss, 8);
        const float rinv = 1.0f / sqrtf(ss * (1.0f / 128.0f) + EPS);
        const size_t gro = (size_t)(t0 + t) * NP + h * 128 + cc;
        float so[8], sz[8]; unpack8(*(const u32x4*)(PROJ + gro + C_O), so); unpack8(*(const u32x4*)(PROJ + gro + C_ZA), sz);
        float y[8];
#pragma unroll
        for (int j = 0; j < 8; ++j) y[j] = hv[j] * rinv * nw[cc + j] * so[j] * sz[j];
        *(u32x4*)(YS + (size_t)(t0 + t) * DM + h * 128 + cc) = pack8(y); }
}

__device__ __forceinline__ void gmlp_unit(Frame& F, int unit, int l) {
    PHASE_TID();
    const int c = unit >> 3, g = unit & 7, t0 = c * LCH;
    const bf16_t* PROJ = (const bf16_t*)(F.ws + WS_PROJ);
    lds_u8* Ws = F.lds; lds_u8* Vn = F.lds + TILE_B; LAS float* st = (LAS float*)(F.lds + 2 * TILE_B);
    LAS float* sMean = (LAS float*)(F.lds + SCAL_OFF); LAS float* sRstd = sMean + 128;
    __syncthreads();
    {
        const int row = tid >> 2, q4 = tid & 3; const bf16_t* p = PROJ + (size_t)(t0 + row) * NP + C_VG + q4 * 256; float s = 0.f, s2 = 0.f;
#pragma unroll 8
        for (int j = 0; j < 32; ++j) { float f[8]; unpack8(*(const u32x4*)(p + j * 8), f);
#pragma unroll
            for (int i = 0; i < 8; ++i) { s += f[i]; s2 += f[i] * f[i]; } }
        s += __shfl_xor(s, 1); s += __shfl_xor(s, 2); s2 += __shfl_xor(s2, 1); s2 += __shfl_xor(s2, 2);
        const float mean = s * (1.0f / 1024.0f), var = fmaxf(s2 * (1.0f / 1024.0f) - mean * mean, 0.f);
        if (q4 == 0) { sMean[row] = mean; sRstd[row] = 1.0f / sqrtf(var + EPS); }
    }
    __syncthreads();
    const float* lnw = F.in[6] + (size_t)l * BW + g * 128; const float* lnb = F.in[7] + (size_t)l * BW + g * 128;
    tile_g2l(Ws, (const bf16_t*)(F.ws + WS_GWT) + ((size_t)l * 8 + g) * 16384, 128, tid);
#pragma unroll
    for (int p = 0; p < 4; ++p) { const int row = p * 32 + (tid >> 4), cc = (tid & 15) * 8;
        float f[8]; unpack8(*(const u32x4*)(PROJ + (size_t)(t0 + row) * NP + C_VG + g * 128 + cc), f); const float mean = sMean[row], rstd = sRstd[row];
#pragma unroll
        for (int j = 0; j < 8; ++j) f[j] = (f[j] - mean) * rstd * lnw[cc + j] + lnb[cc + j];
        *(LAS u32x4*)(Vn + row * TP + cc * 2) = pack8(f); }
    __syncthreads();
    f32x4 acc[2][4];
    mm128<false, true>(acc, Ws, Vn, wave, lane);
    acc_to_stage(acc, st, wave, lane);
    __syncthreads();
    const float* bs = F.in[9] + ((size_t)l * 8 + g) * 128; bf16_t* YS = (bf16_t*)(F.ws + WS_YS);
#pragma unroll
    for (int p = 0; p < 4; ++p) { const int t = p * 32 + (tid >> 4), cc = (tid & 15) * 8; const size_t gro = (size_t)(t0 + t) * NP + g * 128 + cc;
        float uf[8], zf[8]; unpack8(*(const u32x4*)(PROJ + gro + C_U), uf); unpack8(*(const u32x4*)(PROJ + gro + C_ZB), zf); const float b = bs[t];
        float y[8];
#pragma unroll
        for (int j = 0; j < 8; ++j) y[j] = uf[j] * (st[t * SP + cc + j] + b) * zf[j];
        *(u32x4*)(YS + (size_t)(t0 + t) * DM + BW + g * 128 + cc) = pack8(y); }
}

__device__ __forceinline__ void rglru_conv8(const bf16_t* PROJ, int tg, int chg, const float* cw, const float* cb, float (&x)[8]) {
#pragma unroll
    for (int j = 0; j < 8; ++j) x[j] = cb[chg + j];
#pragma unroll
    for (int k = 0; k < 4; ++k) { const int ts = tg - 3 + k; if (ts >= 0) { float f[8]; unpack8(*(const u32x4*)(PROJ + (size_t)ts * NP + C_XC + chg), f);
#pragma unroll
        for (int j = 0; j < 8; ++j) x[j] += cw[k * BW + chg + j] * f[j]; } }
}
__device__ __forceinline__ void rglru_c1(Frame& F, int unit, int l) {
    PHASE_TID();
    const int c = unit >> 3, n = unit & 7, t0 = c * LCH;
    const bf16_t* PROJ = (const bf16_t*)(F.ws + WS_PROJ);
    const float* cw = F.in[10] + (size_t)l * 4 * BW; const float* cb = F.in[11] + (size_t)l * BW;
    lds_u8* Xs = F.lds; lds_u8* Wr = F.lds + TILE_B; lds_u8* Wi = F.lds + 2 * TILE_B;
    LAS float* stR = (LAS float*)F.lds; LAS float* stI = (LAS float*)(F.lds + 2 * TILE_B);
    LAS float* sSegA = (LAS float*)(F.lds + SCAL_OFF); LAS float* sSegH = sSegA + 512;
    __syncthreads();
    float xv[4][8];
#pragma unroll
    for (int p = 0; p < 4; ++p) { const int t = p * 32 + (tid >> 4), cc = (tid & 15) * 8; rglru_conv8(PROJ, t0 + t, n * 128 + cc, cw, cb, xv[p]);
        *(LAS u32x4*)(Xs + t * TP + cc * 2) = pack8(xv[p]); }
    const bf16_t* RWT = (const bf16_t*)(F.ws + WS_RWT) + ((size_t)l * 8 + n) * 256 * 128;
    tile_g2l(Wr, RWT, 128, tid); tile_g2l(Wi, RWT + 128 * 128, 128, tid);
    __syncthreads();
    f32x4 accR[2][4], accI[2][4];
    mm128<false, false>(accR, Xs, Wr, wave, lane);
    mm128<false, false>(accI, Xs, Wi, wave, lane);
    __syncthreads();
    acc_to_stage(accR, stR, wave, lane); acc_to_stage(accI, stI, wave, lane);
    __syncthreads();
    {
        const int cc = (tid & 15) * 8, chg = n * 128 + cc;
        const float* bgate = F.in[13] + (size_t)l * 2 * BW; const float* ap = F.in[14] + (size_t)l * BW;
        float spl8[8], br[8], bi[8];
#pragma unroll
        for (int j = 0; j < 8; ++j) { const float av = ap[chg + j]; spl8[j] = -8.0f * ((av > 0.f) ? log1pf(expf(-av)) : (-av + log1pf(expf(av)))); br[j] = bgate[chg + j]; bi[j] = bgate[BW + chg + j]; }
#pragma unroll
        for (int p = 0; p < 4; ++p) { const int t = p * 32 + (tid >> 4);
#pragma unroll
            for (int j = 0; j < 8; ++j) { const float r = sigmoidf_(stR[t * SP + cc + j] + br[j]), ig = sigmoidf_(stI[t * SP + cc + j] + bi[j]);
                const float la = r * spl8[j]; const float a = __builtin_amdgcn_exp2f(1.44269504f * la);
                const float x2 = 2.0f * la;
                const float ser = -x2 * (1.0f + x2 * (0.5f + x2 * (0.16666667f + x2 * (0.041666668f + x2 * (0.0083333338f + x2 * 0.0013888889f)))));
                const float em = (x2 > -0.5f) ? ser : (1.0f - a * a);
                float mult = sqrtf(fmaxf(em, 0.f)); if (t0 + t == 0) mult = 1.0f;
                stR[t * SP + cc + j] = a; stI[t * SP + cc + j] = mult * ig * xv[p][j]; } }
    }
    __syncthreads();
    {
        const int ch = tid & 127, sg = tid >> 7, tb = sg * 32;
        float hh = 0.f, A = 1.f;
#pragma unroll 8
        for (int t = 0; t < 32; ++t) { const float a = stR[(tb + t) * SP + ch], bx = stI[(tb + t) * SP + ch]; hh = a * hh + bx; A *= a; }
        sSegA[sg * 128 + ch] = A; sSegH[sg * 128 + ch] = hh;
        __syncthreads();
        float hc = 0.f, Ac = 1.f;
        for (int q = 0; q < sg; ++q) { const float a = sSegA[q * 128 + ch]; hc = a * hc + sSegH[q * 128 + ch]; Ac *= a; }
        float* HL = (float*)(F.ws + WS_HLOC) + (size_t)(t0 + tb) * BW + n * 128 + ch; float* AC = (float*)(F.ws + WS_ACUM) + (size_t)(t0 + tb) * BW + n * 128 + ch;
        hh = hc; A = Ac;
#pragma unroll 8
        for (int t = 0; t < 32; ++t) { const float a = stR[(tb + t) * SP + ch], bx = stI[(tb + t) * SP + ch]; hh = a * hh + bx; A *= a; HL[(size_t)t * BW] = hh; AC[(size_t)t * BW] = A; }
        if (sg == 3) { float* AP = (float*)(F.ws + WS_APROD); AP[c * BW + n * 128 + ch] = A; AP[65536 + c * BW + n * 128 + ch] = hh; }
    }
}
__device__ __forceinline__ void rglru_c3(Frame& F, int unit) {
    PHASE_TID();
    const int c = unit >> 3, n = unit & 7, t0 = c * LCH;
    const bf16_t* PROJ = (const bf16_t*)(F.ws + WS_PROJ);
    LAS float* sCarry = (LAS float*)(F.lds + SCAL_OFF);
    __syncthreads();
    if (tid < 128) { const float* AP = (const float*)(F.ws + WS_APROD) + n * 128 + tid; float carry = 0.f;
        for (int cp = 0; cp < c; ++cp) carry = AP[cp * BW] * carry + AP[65536 + cp * BW];
        sCarry[tid] = carry; }
    __syncthreads();
    const float* HL = (const float*)(F.ws + WS_HLOC); const float* AC = (const float*)(F.ws + WS_ACUM); bf16_t* YS = (bf16_t*)(F.ws + WS_YS);
#pragma unroll
    for (int p = 0; p < 4; ++p) { const int t = p * 32 + (tid >> 4), cc = (tid & 15) * 8; const size_t o = (size_t)(t0 + t) * BW + n * 128 + cc;
        const f32x4 h0 = *(const f32x4*)(HL + o), h1 = *(const f32x4*)(HL + o + 4), a0 = *(const f32x4*)(AC + o), a1 = *(const f32x4*)(AC + o + 4);
        float zf[8]; unpack8(*(const u32x4*)(PROJ + (size_t)(t0 + t) * NP + C_ZC + n * 128 + cc), zf);
        float y[8];
#pragma unroll
        for (int j = 0; j < 4; ++j) { y[j] = (h0[j] + a0[j] * sCarry[cc + j]) * zf[j]; y[4 + j] = (h1[j] + a1[j] * sCarry[cc + 4 + j]) * zf[4 + j]; }
        *(u32x4*)(YS + (size_t)(t0 + t) * DM + 2 * BW + n * 128 + cc) = pack8(y); }
}
__device__ __forceinline__ void sconv_unit(Frame& F, int unit, int l) {
    PHASE_TID();
    const int c = unit >> 3, n = unit & 7, t0 = c * LCH;
    const bf16_t* PROJ = (const bf16_t*)(F.ws + WS_PROJ); const float* sw = F.in[15] + (size_t)l * 3 * BW; bf16_t* YS = (bf16_t*)(F.ws + WS_YS);
#pragma unroll
    for (int p = 0; p < 4; ++p) { const int t = t0 + p * 32 + (tid >> 4), chg = n * 128 + (tid & 15) * 8;
        float acc[8];
#pragma unroll
        for (int j = 0; j < 8; ++j) acc[j] = 0.f;
#pragma unroll
        for (int k = 0; k < 3; ++k) { const int ts = t - 2 + k; if (ts >= 0) { float cg[8], xd[8]; unpack8(*(const u32x4*)(PROJ + (size_t)ts * NP + C_CG + chg), cg); unpack8(*(const u32x4*)(PROJ + (size_t)ts * NP + C_XD + chg), xd);
#pragma unroll
            for (int j = 0; j < 8; ++j) acc[j] += sw[k * BW + chg + j] * (cg[j] * xd[j]); } }
        float bg[8], zf[8]; unpack8(*(const u32x4*)(PROJ + (size_t)t * NP + C_BG + chg), bg); unpack8(*(const u32x4*)(PROJ + (size_t)t * NP + C_ZD + chg), zf);
        float y[8];
#pragma unroll
        for (int j = 0; j < 8; ++j) y[j] = bg[j] * acc[j] * zf[j];
        *(u32x4*)(YS + (size_t)t * DM + 3 * BW + chg) = pack8(y); }
}

__global__ void __launch_bounds__(512, 2) hybrid_fwd(Args args) {
    extern __shared__ __attribute__((aligned(16))) unsigned char lds_raw[];
    Frame F;
    F.lds = (lds_u8*)lds_raw;
    F.G = gridDim.x; F.bid = blockIdx.x;
#pragma unroll
    for (int i = 0; i < 18; ++i) F.in[i] = args.in[i];
    F.out = args.out; F.ws = args.ws;
    volatile LAS unsigned* MISC = (volatile LAS unsigned*)(F.lds + MISC_OFF);
    if (threadIdx.x < 64) MISC[threadIdx.x] = 0u;
    __syncthreads();
    XcdBarrier bar = xcd_barrier_post((unsigned*)(F.ws + WS_CTL) + CW_BAR, MISC + 8);
#define GRID_BAR() xcd_barrier(bar)

    for (int rep = 0; rep < REP_P0; ++rep) { p0_prologue(F); GRID_BAR(); }
    for (int l = 0; l <= DEPTH; ++l) {
        for (int rep = 0; rep < REP_NORM; ++rep) norm_phase(F, l);
        if (l == DEPTH) break;
        GRID_BAR();
        for (int rep = 0; rep < REP_B; ++rep) {
            pg8::Gemm g{(const bf16_t*)(F.ws + WS_H), (const bf16_t*)(F.ws + WS_WIN + (size_t)l * WIN_L), DM, DM, DM};
            pg8::StaticOrder S; S.init(SEQ, NP, F.G, F.bid, 1);
            pg8::EpiProj E{(bf16_t*)(F.ws + WS_PROJ)};
            pg8::gemm_phase<pg8::EpiProj>(F.lds, g, S, E);
            GRID_BAR();
        }
        for (int rep = 0; rep < REP_MIX; ++rep) {
        for (int u = F.bid; u < 512; u += F.G) mlstm_c1(F, u);
        for (int u = F.bid; u < 512; u += F.G) rglru_c1(F, u, l);
        for (int u = F.bid; u < 512; u += F.G) gmlp_unit(F, u, l);
        for (int u = F.bid; u < 512; u += F.G) sconv_unit(F, u, l);
        GRID_BAR();
        mlstm_c2(F);
        GRID_BAR();
        for (int u = F.bid; u < 512; u += F.G) mlstm_c3(F, u, l);
        for (int u = F.bid; u < 512; u += F.G) rglru_c3(F, u);
        GRID_BAR();
        }
        for (int rep = 0; rep < REP_D; ++rep) {
            pg8::Gemm g{(const bf16_t*)(F.ws + WS_YS), (const bf16_t*)(F.ws + WS_WBR + (size_t)l * WSQ_L), DM, DM, BW};
            pg8::StaticOrder S; S.init(SEQ, DM, F.G, F.bid, 4);
            pg8::EpiMerge E{(const bf16_t*)(F.ws + WS_PROJ) + C_G, (bf16_t*)(F.ws + WS_MERGED)};
            __syncthreads();
            pg8::gemm_phase<pg8::EpiMerge>(F.lds, g, S, E);
            GRID_BAR();
        }
        for (int rep = 0; rep < REP_E; ++rep) {
            pg8::Gemm g{(const bf16_t*)(F.ws + WS_MERGED), (const bf16_t*)(F.ws + WS_WOUT + (size_t)l * WSQ_L), DM, DM, DM};
            pg8::StaticOrder S; S.init(SEQ, DM, F.G, F.bid, 1);
            pg8::EpiOut E{(float*)(F.ws + WS_OUT), (float*)(F.ws + WS_SS)};
            pg8::gemm_phase<pg8::EpiOut>(F.lds, g, S, E);
            GRID_BAR();
        }
    }
}

extern "C" void kernel_launch(void* const* d_in, const int* in_sizes, int n_in, void* d_out, int out_size, void* d_ws, size_t ws_size, hipStream_t stream) {
    static int grid = 0;
    if (grid == 0) {
        if (n_in != 18 || in_sizes[0] != SEQ * DM || out_size != SEQ * DM || ws_size < WS_END) {
            fprintf(stderr, "kernel_launch: unexpected problem: n_in %d in0 %d out %d ws %zu (need %zu)\n", n_in, n_in > 0 ? in_sizes[0] : -1, out_size, ws_size, (size_t)WS_END); grid = -1; return; }
        int dev = 0, cus = 0, per_cu = 0;
        if (hipGetDevice(&dev) != hipSuccess || hipDeviceGetAttribute(&cus, hipDeviceAttributeMultiprocessorCount, dev) != hipSuccess) { fprintf(stderr, "kernel_launch: device query failed\n"); grid = -1; return; }
        if (hipFuncSetAttribute((const void*)hybrid_fwd, hipFuncAttributeMaxDynamicSharedMemorySize, LDS_BYTES) != hipSuccess) { fprintf(stderr, "kernel_launch: hipFuncSetAttribute failed\n"); grid = -1; return; }
        if (hipOccupancyMaxActiveBlocksPerMultiprocessor(&per_cu, (const void*)hybrid_fwd, 512, LDS_BYTES) != hipSuccess || per_cu < 1)
            fprintf(stderr, "kernel_launch: note: occupancy query reports %d workgroups per CU\n", per_cu);
        (void)hipGetLastError();
        grid = cus;
    }
    if (grid < 0) return;
    if (hipMemsetAsync((char*)d_ws + WS_CTL, 0, CTL_ZERO_BYTES, stream) != hipSuccess) { fprintf(stderr, "kernel_launch: memset failed\n"); return; }
    Args a{};
    for (int i = 0; i < 18; ++i) a.in[i] = (const float*)d_in[i];
    a.out = (float*)d_out; a.ws = (unsigned char*)d_ws;
    hipLaunchKernelGGL(hybrid_fwd, dim3(grid), dim3(512), LDS_BYTES, stream, a);
    const hipError_t le = hipPeekAtLastError();
    if (le != hipSuccess) fprintf(stderr, "kernel_launch: launch failed: %s\n", hipGetErrorName(le));
}
```

```cpp
#include <hip/hip_runtime.h>
#include <cstdio>
#include <cstdint>

#define LAS __attribute__((address_space(3)))
#define GAS __attribute__((address_space(1)))
typedef unsigned short bf16_t;
typedef short bf16x8 __attribute__((ext_vector_type(8)));
typedef short bf16x4 __attribute__((ext_vector_type(4)));
typedef float f32x4 __attribute__((ext_vector_type(4)));
typedef float f32x2 __attribute__((ext_vector_type(2)));
typedef unsigned u32x4 __attribute__((ext_vector_type(4)));
typedef unsigned u32x2 __attribute__((ext_vector_type(2)));
typedef LAS unsigned char lds_u8;
typedef __bf16 bf16x2_t __attribute__((ext_vector_type(2)));

#ifndef REP_P0
#define REP_P0 1
#endif
#ifndef REP_NORM
#define REP_NORM 1
#endif
#ifndef REP_B
#define REP_B 1
#endif
#ifndef REP_MIX
#define REP_MIX 1
#endif
#ifndef REP_U1
#define REP_U1 1
#endif
#ifndef REP_U2
#define REP_U2 1
#endif
#ifndef REP_U3
#define REP_U3 1
#endif
#ifndef REP_U4
#define REP_U4 1
#endif
#ifndef REP_C1
#define REP_C1 1
#endif
#ifndef REP_C2
#define REP_C2 1
#endif
#ifndef REP_C3
#define REP_C3 1
#endif
#ifndef REP_D
#define REP_D 1
#endif
#ifndef REP_E
#define REP_E 1
#endif
#ifndef PROBE_TAIL
#define PROBE_TAIL 0
#endif
#ifndef STAG_B
#define STAG_B 0u
#endif
#ifndef STAG_D
#define STAG_D 0u
#endif
#ifndef STAG_E
#define STAG_E 0u
#endif
constexpr int DM = 4096, SEQ = 8192, DEPTH = 2, BW = 1024, NHEAD = 8, LCH = 128, NCH = 64;
constexpr int PROJ_W = 30736, NP = 30720;
constexpr int C_Q = 0, C_K = 1024, C_V = 2048, C_OZ = 3072, C_UZ = 5120, C_VG = 7168, C_XC = 8192, C_ZC = 9216, C_BZ = 10240, C_CX = 12288, C_G = 14336;
constexpr float EPS = 1e-6f;

constexpr size_t MiB = 1u << 20;
constexpr size_t WS_CTL = 0, CTL_ZERO_BYTES = 1 * MiB;
constexpr size_t WS_WIN = 16 * MiB;
constexpr size_t WIN_L = (size_t)NP * DM * 2;
constexpr size_t WS_WBR = 496 * MiB;
constexpr size_t WS_WOUT = 560 * MiB;
constexpr size_t WSQ_L = (size_t)DM * DM * 2;
constexpr size_t WS_SPL = 624 * MiB;
constexpr size_t WS_LNS = 624 * MiB + 65536;
constexpr size_t WS_GWT = 625 * MiB;
constexpr size_t WS_RWT = 626 * MiB;
constexpr size_t WS_H = 640 * MiB;
constexpr size_t WS_PROJ = 704 * MiB;
constexpr size_t WS_YS = 1184 * MiB;
constexpr size_t WS_MERGED = 1248 * MiB;
constexpr size_t WS_OUT = 1312 * MiB;
constexpr size_t OUT_L = (size_t)SEQ * DM * 2;
constexpr size_t WS_SS1 = 1440 * MiB;
constexpr size_t WS_SS = 1568 * MiB;
constexpr size_t WS_GATES = 1570 * MiB;
constexpr size_t WS_TB = 1571 * MiB;
constexpr size_t WS_XR = 1696 * MiB;
constexpr size_t WS_DC = 1576 * MiB;
constexpr size_t WS_DN = 1608 * MiB;
constexpr size_t WS_CST = 1610 * MiB;
constexpr size_t WS_NST = 1626 * MiB;
constexpr size_t WS_HLOC = 1628 * MiB;
constexpr size_t WS_ACUM = 1660 * MiB;
constexpr size_t WS_APROD = 1692 * MiB;
constexpr size_t WS_END = 1760 * MiB;
constexpr int CW_BAR = 4096;

constexpr int LDS_BYTES = 163840;
constexpr int MISC_OFF = LDS_BYTES - 256;
constexpr int TP = 272;
constexpr int TILE_B = 128 * TP;
constexpr int SP = 132;
constexpr int SCAL_OFF = 4 * TILE_B;

__device__ __forceinline__ float bf2f(unsigned short b) { return __uint_as_float(((unsigned)b) << 16); }
__device__ __forceinline__ unsigned f2bf(float f) { unsigned u = __float_as_uint(f); return (u + 0x7fffu + ((u >> 16) & 1u)) >> 16; }
typedef float f32x2_t __attribute__((ext_vector_type(2)));
typedef __bf16 bf16x2_t __attribute__((ext_vector_type(2)));
__device__ __forceinline__ unsigned cvt_pk_bf16(float lo, float hi) { const f32x2_t v = {lo, hi}; const bf16x2_t r = __builtin_convertvector(v, bf16x2_t); return __builtin_bit_cast(unsigned, r); }
__device__ __forceinline__ unsigned pk2(float lo, float hi) { return cvt_pk_bf16(lo, hi); }
__device__ __forceinline__ void unpack8(const u32x4 v, float (&f)[8]) {
    f[0] = __uint_as_float(v.x << 16); f[1] = __uint_as_float(v.x & 0xffff0000u); f[2] = __uint_as_float(v.y << 16); f[3] = __uint_as_float(v.y & 0xffff0000u);
    f[4] = __uint_as_float(v.z << 16); f[5] = __uint_as_float(v.z & 0xffff0000u); f[6] = __uint_as_float(v.w << 16); f[7] = __uint_as_float(v.w & 0xffff0000u);
}
__device__ __forceinline__ u32x4 pack8(const float (&f)[8]) { u32x4 w; w.x = pk2(f[0], f[1]); w.y = pk2(f[2], f[3]); w.z = pk2(f[4], f[5]); w.w = pk2(f[6], f[7]); return w; }
__device__ __forceinline__ float wave_sum(float v) {
#pragma unroll
    for (int o = 1; o < 64; o <<= 1) v += __shfl_xor(v, o);
    return v;
}
__device__ __forceinline__ float sigmoidf_(float x) { return __builtin_amdgcn_rcpf(1.0f + __builtin_amdgcn_exp2f(-1.44269504f * x)); }
#define LDS_WAIT() asm volatile("s_waitcnt lgkmcnt(0)" ::: "memory")
#define VM_WAIT() asm volatile("s_waitcnt vmcnt(0)" ::: "memory")

#define XB_TMO      128
#define XB_XCNT(j)  (256  + 64 * (j))
#define XB_XSUB(j)  (1280 + 64 * (j))
#define XB_XGEN(j)  (2304 + 64 * (j))
#define XB_TOP      3328
#define XB_TOPGEN   3392
#define XCD_BAR_WORDS 3456
#define XB_SPIN_CAP (1u << 18)

__device__ __forceinline__ unsigned xb_ld(unsigned* p)              { return __hip_atomic_load(p, __ATOMIC_RELAXED, __HIP_MEMORY_SCOPE_AGENT); }
__device__ __forceinline__ unsigned xb_add(unsigned* p, unsigned v) { return __hip_atomic_fetch_add(p, v, __ATOMIC_RELAXED, __HIP_MEMORY_SCOPE_AGENT); }
__device__ __forceinline__ unsigned xb_xcc_id() { return (unsigned)__builtin_amdgcn_s_getreg((3 << 11) | 20) & 0xFu; }
#define XB_SPIN(cond, bar) do { unsigned _sp = 0; while (cond) { __builtin_amdgcn_s_sleep(1); \
    if ((++_sp & 255u) == 0u) { if (xb_ld(&(bar)[XB_TMO])) break; if (_sp > XB_SPIN_CAP) { atomicAdd(&(bar)[XB_TMO], 1u); break; } } } } while (0)

struct XcdBarrier { unsigned* bar; unsigned x; volatile LAS unsigned* st; };

__device__ __forceinline__ XcdBarrier xcd_barrier_post(unsigned* bar, volatile LAS unsigned* st) {
    XcdBarrier b; b.bar = bar; b.x = xb_xcc_id(); b.st = st;
    if (threadIdx.x == 0) (void)xb_add(&bar[XB_XCNT(b.x)], 1u);
    return b;
}
__device__ __forceinline__ void xcd_barrier_complete(unsigned* bar, unsigned x, unsigned& nloc, unsigned& nx) {
    const unsigned G = gridDim.x * gridDim.y * gridDim.z;
    unsigned sum, cnt, mine, sp = 0u;
    for (;;) {
        sum = 0u; cnt = 0u; mine = 0u;
#pragma unroll
        for (unsigned j = 0; j < 16; ++j) { const unsigned c = xb_ld(&bar[XB_XCNT(j)]); sum += c; cnt += (c > 0u) ? 1u : 0u; mine = (j == x) ? c : mine; }
        if (sum == G) break;
        __builtin_amdgcn_s_sleep(1);
        if ((++sp & 255u) == 0u) { if (xb_ld(&bar[XB_TMO])) break; if (sp > XB_SPIN_CAP) { atomicAdd(&bar[XB_TMO], 1u); break; } }
    }
    nloc = mine > 0u ? mine : 1u; nx = cnt > 0u ? cnt : 1u;
}
__device__ __forceinline__ void xcd_barrier(const XcdBarrier& b) {
    asm volatile("s_waitcnt vmcnt(0)" ::: "memory");
    __syncthreads();
    if (threadIdx.x == 0) {
        unsigned* bar = b.bar;
        __builtin_amdgcn_s_waitcnt(0);
        unsigned nloc = b.st[0], nx = b.st[1];
        if (nloc == 0u) { xcd_barrier_complete(bar, b.x, nloc, nx); b.st[0] = nloc; b.st[1] = nx; }
        const unsigned old = xb_add(&bar[XB_XSUB(b.x)], 1u);
        const unsigned gen = old / nloc;
        if (old + 1u == (gen + 1u) * nloc) {
            __builtin_amdgcn_fence(__ATOMIC_RELEASE, "agent");
            asm volatile("s_waitcnt vmcnt(0)" ::: "memory");
            const unsigned og = xb_add(&bar[XB_TOP], 1u);
            const unsigned tg = og / nx;
            if (og + 1u == (tg + 1u) * nx) xb_add(&bar[XB_TOPGEN], 1u);
            else XB_SPIN(xb_ld(&bar[XB_TOPGEN]) == tg, bar);
            __builtin_amdgcn_fence(__ATOMIC_ACQUIRE, "agent");
            xb_add(&bar[XB_XGEN(b.x)], 1u);
            asm volatile("s_waitcnt vmcnt(0)" ::: "memory");
        } else {
            XB_SPIN(xb_ld(&bar[XB_XGEN(b.x)]) == gen, bar);
            __builtin_amdgcn_fence(__ATOMIC_ACQUIRE, "agent");
            asm volatile("s_waitcnt vmcnt(0)" ::: "memory");
        }
    }
    __syncthreads();
}

namespace pg8 {
constexpr int BM = 256, BK = 64, HALF = 128, HTB = HALF * BK * 2, STAGE_BYTES = 8 * HTB, NXCD = 8, WGM = 8;
__host__ __device__ __forceinline__ int lds_byte(int r, int c) { const int st = (r >> 4) * 2 + (c >> 5), rr = r & 15, cc = c & 31, ob = rr * 64 + cc * 2; return st * 1024 + (ob ^ (((ob >> 9) & 1) << 5)); }
__host__ __device__ __forceinline__ void stage_rc(int b, int& R, int& C) { const int st = b / 1024, sb = b % 1024, swz = sb ^ (((sb >> 9) & 1) << 5); R = (st >> 1) * 16 + swz / 64; C = (st & 1) * 32 + (swz % 64) / 2; }
__host__ __device__ __forceinline__ int perm32(int rho) { const int n = rho >> 4, i = rho & 15; return 8 * (i >> 2) + 4 * n + (i & 3); }

struct Unit { int pm, pn, g; };
struct Gemm { const bf16_t* A; const bf16_t* Bt; int lda, ldb, K; };

struct StaticOrder {
    int nM, nN, nwg, G, c, gdiv, same, i0, i1;
    __device__ void init(int M, int N, int G_, int c_, int gdiv_) { nM = M / BM; nN = N / BM; nwg = nM * nN; G = G_; c = c_; gdiv = gdiv_; same = 0; i0 = 0; i1 = 1 << 30; }
    __device__ bool next(int ir, Unit& u) const {
        const int i = ir + i0; if (i >= i1) return false;
        const int ti = i / gdiv; u.g = i - ti * gdiv;
        const long L = (long)ti * G + c; if (L >= nwg) return false;
        int wgid = (int)L; { const int q = nwg / NXCD, r = nwg % NXCD, xcd = wgid % NXCD, off = wgid / NXCD; wgid = (xcd < r ? xcd * (q + 1) : r * (q + 1) + (xcd - r) * q) + off; }
        const int nig = WGM * nN, gid = wgid / nig, fm = gid * WGM, gsz = (nM - fm) < WGM ? (nM - fm) : WGM;
        u.pm = fm + ((wgid % nig) % gsz); u.pn = (wgid % nig) / gsz; if (same) { u.pm = 0; u.pn = 0; } return true;
    }
};


struct EpiProj {
    static constexpr bool PERM = true, CHAIN = false;
    bf16_t* O; lds_u8* xbuf; int skip;
    __device__ __forceinline__ void gate_tile(f32x4 (&acc)[2][2][4][2], const Unit& u, int wr, int wc, int fr, int fq) const {
        const int j = u.pn - 56, row0 = u.pm * BM + wr * 64 + fr, dl0 = 16 * wc + 8 * (fq >> 1);
#pragma unroll
        for (int ai = 0; ai < 2; ++ai)
#pragma unroll
            for (int m = 0; m < 4; ++m) { bf16_t* rowp = O + (size_t)(row0 + ai * HALF + m * 16) * NP + C_G + 64 * j + dl0;
                f32x4 d[4], s[4];
#pragma unroll
                for (int g = 0; g < 4; ++g) {
#pragma unroll
                    for (int q = 0; q < 4; ++q) d[g][q] = 1.0f + __builtin_amdgcn_exp2f(acc[ai][g >> 1][m][g & 1][q]);
#pragma unroll
                    for (int q = 0; q < 4; ++q) s[g][q] = __builtin_amdgcn_rcpf(d[g][q]); }
                u32x2 w[4];
#pragma unroll
                for (int g = 0; g < 4; ++g) { f32x4 v = s[g];
                    if (g < 3) {
#pragma unroll
                        for (int q = 0; q < 4; ++q) v[q] *= fminf(d[g + 1][q], 1e12f); }
                    w[g].x = cvt_pk_bf16(v[0], v[1]); w[g].y = cvt_pk_bf16(v[2], v[3]); }
#pragma unroll
                for (int g = 0; g < 2; ++g) {
                    const auto r0 = __builtin_amdgcn_permlane16_swap(w[g].x, w[g + 2].x, false, false); const auto r1 = __builtin_amdgcn_permlane16_swap(w[g].y, w[g + 2].y, false, false);
                    u32x4 o; o.x = r0[0]; o.y = r1[0]; o.z = r0[1]; o.w = r1[1];
                    *(u32x4*)(rowp + (size_t)(g + 2 * (fq & 1)) * DM) = o; } }
    }
    __device__ __forceinline__ void pair_tile(f32x4 (&acc)[2][2][4][2], const Unit& u, int wr, int wc, int fr, int fq) const {
        const int kind = u.pn < 20 ? 0 : (u.pn < 48 ? 1 : 2);
        const int pb = u.pn < 20 ? 12 : (u.pn < 28 ? 20 : (u.pn < 48 ? 40 : 48));
        const int cbase = (pb == 12 ? C_OZ : (pb == 20 ? C_UZ : (pb == 40 ? C_BZ : C_CX))) + (u.pn - pb) * 128 + wc * 32 + 8 * fq;
        const int row0 = u.pm * BM + wr * 64 + fr;
#pragma unroll
        for (int ai = 0; ai < 2; ++ai)
#pragma unroll
            for (int m = 0; m < 4; ++m) { f32x4 a0 = acc[ai][0][m][0], a1 = acc[ai][0][m][1], b0 = acc[ai][1][m][0], b1 = acc[ai][1][m][1];
                if (kind != 2) { f32x4 e0, e1;
#pragma unroll
                    for (int j = 0; j < 4; ++j) { e0[j] = __builtin_amdgcn_rcpf(1.0f + __builtin_amdgcn_exp2f(b0[j])); e1[j] = __builtin_amdgcn_rcpf(1.0f + __builtin_amdgcn_exp2f(b1[j])); }
                    b0 = b0 * e0 * -0.6931471805599453f; b1 = b1 * e1 * -0.6931471805599453f;
                    if (kind == 0) {
#pragma unroll
                        for (int j = 0; j < 4; ++j) { a0[j] = __builtin_amdgcn_rcpf(1.0f + __builtin_amdgcn_exp2f(a0[j])); a1[j] = __builtin_amdgcn_rcpf(1.0f + __builtin_amdgcn_exp2f(a1[j])); } } }
                a0 = a0 * b0; a1 = a1 * b1;
                u32x4 w; w.x = cvt_pk_bf16(a0[0], a0[1]); w.y = cvt_pk_bf16(a0[2], a0[3]); w.z = cvt_pk_bf16(a1[0], a1[1]); w.w = cvt_pk_bf16(a1[2], a1[3]);
                *(u32x4*)(O + (size_t)(row0 + ai * HALF + m * 16) * NP + cbase) = w; }
    }
    __device__ __forceinline__ void operator()(f32x4 (&acc)[2][2][4][2], const Unit& u, int wr, int wc, int fr, int fq) const {
        if (skip == 1) {
#pragma unroll
            for (int ai = 0; ai < 2; ++ai)
#pragma unroll
                for (int bj = 0; bj < 2; ++bj)
#pragma unroll
                    for (int m = 0; m < 4; ++m) asm volatile("" :: "v"(acc[ai][bj][m][0]), "v"(acc[ai][bj][m][1]));
            return; }
        const int seg = u.pn >> 2;
        if (seg >= 14 && skip == 0) { gate_tile(acc, u, wr, wc, fr, fq); return; }
        if (skip == 0 && ((u.pn >= 12 && u.pn < 28) || (u.pn >= 40 && u.pn < 56))) { pair_tile(acc, u, wr, wc, fr, fq); return; }
        const int mode = (skip == 3 || skip == 5) ? 0 : ((seg >= 14) ? 1 : ((seg == 9) ? 2 : 0));
        const int row0 = u.pm * BM + wr * 64 + fr, col0 = u.pn * BM + wc * 32 + 8 * fq;
#pragma unroll
        for (int ai = 0; ai < 2; ++ai)
#pragma unroll
            for (int m = 0; m < 4; ++m) { bf16_t* rowp = O + (size_t)(row0 + ai * HALF + m * 16) * NP + col0;
                if (skip == 5) rowp = O + (size_t)(u.pm * 120 + u.pn) * 65536 + ((ai * 4 + m) * 2) * 4096 + (wr * 4 + wc) * 512 + (fq * 16 + fr) * 8;
#pragma unroll
                for (int bj = 0; bj < 2; ++bj) { f32x4 v0 = acc[ai][bj][m][0], v1 = acc[ai][bj][m][1];
                    if (mode != 0) {
                        f32x4 e0, e1;
#pragma unroll
                        for (int j = 0; j < 4; ++j) { e0[j] = __builtin_amdgcn_exp2f(v0[j]); e1[j] = __builtin_amdgcn_exp2f(v1[j]); }
#pragma unroll
                        for (int j = 0; j < 4; ++j) { e0[j] = __builtin_amdgcn_rcpf(1.0f + e0[j]); e1[j] = __builtin_amdgcn_rcpf(1.0f + e1[j]); }
                        if (mode == 1) { v0 = e0; v1 = e1; } else { v0 = v0 * e0 * -0.6931471805599453f; v1 = v1 * e1 * -0.6931471805599453f; }
                    }
                    u32x4 w; w.x = cvt_pk_bf16(v0[0], v0[1]); w.y = cvt_pk_bf16(v0[2], v0[3]); w.z = cvt_pk_bf16(v1[0], v1[1]); w.w = cvt_pk_bf16(v1[2], v1[3]);
                    if (skip == 4) asm volatile("" :: "v"(w)); else *(u32x4*)(rowp + (skip == 5 ? bj * 4096 : bj * HALF)) = w; } }
    }
};
struct EpiMerge {
    static constexpr bool PERM = true, CHAIN = true;
    const bf16_t* G; bf16_t* MERGED; int skip;
    __device__ __forceinline__ void operator()(f32x4 (&acc)[2][2][4][2], const Unit& u, int wr, int wc, int fr, int fq) const {
        const int row0 = u.pm * BM + wr * 64 + fr, col0 = u.pn * BM + wc * 32 + 8 * fq;
        const int g = u.g;
        if (skip == 1 && g < 3) return;
#pragma unroll
        for (int ai = 0; ai < 2; ++ai) { u32x4 gw[4][2];
#pragma unroll
            for (int m = 0; m < 4; ++m)
#pragma unroll
                for (int bj = 0; bj < 2; ++bj) gw[m][bj] = *(const u32x4*)(G + (size_t)(row0 + ai * HALF + m * 16) * NP + (size_t)g * DM + col0 + bj * HALF);
#pragma unroll
            for (int m = 0; m < 4; ++m) { const size_t r = (size_t)(row0 + ai * HALF + m * 16);
#pragma unroll
                for (int bj = 0; bj < 2; ++bj) { const int c = col0 + bj * HALF;
                    float gf[8]; unpack8(gw[m][bj], gf);
                    f32x4 v0 = acc[ai][bj][m][0], v1 = acc[ai][bj][m][1];
                    v0[0] *= gf[0]; v0[1] *= gf[1]; v0[2] *= gf[2]; v0[3] *= gf[3]; v1[0] *= gf[4]; v1[1] *= gf[5]; v1[2] *= gf[6]; v1[3] *= gf[7];
                    if (g < 3) { acc[ai][bj][m][0] = v0; acc[ai][bj][m][1] = v1; }
                    else { u32x4 w; w.x = cvt_pk_bf16(v0[0], v0[1]); w.y = cvt_pk_bf16(v0[2], v0[3]); w.z = cvt_pk_bf16(v1[0], v1[1]); w.w = cvt_pk_bf16(v1[2], v1[3]);
                        *(u32x4*)(MERGED + r * DM + c) = w; } } }
            asm volatile("" ::: "memory"); }
    }
};
struct EpiOut {
    static constexpr bool PERM = true, CHAIN = false;
    bf16_t* OUT; float* SS;
    __device__ __forceinline__ void operator()(f32x4 (&acc)[2][2][4][2], const Unit& u, int wr, int wc, int fr, int fq) const {
        const int row0 = u.pm * BM + wr * 64 + fr, col0 = u.pn * BM + wc * 32 + 8 * fq;
#pragma unroll
        for (int ai = 0; ai < 2; ++ai)
#pragma unroll
            for (int m = 0; m < 4; ++m) { const size_t r = (size_t)(row0 + ai * HALF + m * 16); bf16_t* rowp = OUT + r * DM + col0; float q = 0.f;
#pragma unroll
                for (int bj = 0; bj < 2; ++bj) { const f32x4 v0 = acc[ai][bj][m][0], v1 = acc[ai][bj][m][1];
                    q += (v0[0] * v0[0] + v0[1] * v0[1]) + (v0[2] * v0[2] + v0[3] * v0[3]) + (v1[0] * v1[0] + v1[1] * v1[1]) + (v1[2] * v1[2] + v1[3] * v1[3]);
                    u32x4 w; w.x = cvt_pk_bf16(v0[0], v0[1]); w.y = cvt_pk_bf16(v0[2], v0[3]); w.z = cvt_pk_bf16(v1[0], v1[1]); w.w = cvt_pk_bf16(v1[2], v1[3]);
                    *(u32x4*)(rowp + bj * HALF) = w; }
                q += __shfl_xor(q, 16); q += __shfl_xor(q, 32);
                if (fq == 0) SS[r * 64 + u.pn * 4 + wc] = q; }
    }
};

#ifndef PG8_SP2
#define PG8_SP2 1
#endif
template <class Epi>
__device__ __forceinline__ void gemm_phase(lds_u8* lds, const Gemm g, const StaticOrder& S, const Epi& E, unsigned stagger_ticks) {
    if (stagger_ticks) { const unsigned long long t0 = __builtin_amdgcn_s_memrealtime(); const unsigned long long dl = (unsigned long long)(xb_xcc_id() & 7u) * stagger_ticks;
        while (__builtin_amdgcn_s_memrealtime() - t0 < dl) __builtin_amdgcn_s_sleep(8); }
    int tid = threadIdx.x; asm volatile("" : "+v"(tid));
    const int wid = __builtin_amdgcn_readfirstlane(tid >> 6), lane = tid & 63, wr = wid >> 2, wc = wid & 3, fr = lane & 15, fq = lane >> 4;
    const int K = g.K, nt = K / BK;
    unsigned voffA[2], voffB[2];
#pragma unroll
    for (int i = 0; i < 2; ++i) { int R, C; stage_rc(tid * 16 + i * 8192, R, C); const int Rb = Epi::PERM ? ((R & ~31) + perm32(R & 31)) : R;
        voffA[i] = (unsigned)(R * g.lda + C) * 2u; voffB[i] = (unsigned)(Rb * g.ldb + C) * 2u; }
    const size_t kstep = (size_t)(BK * 2);
    const size_t hstepA = (size_t)HALF * g.lda * 2, hstepB = (size_t)HALF * g.ldb * 2;
    const size_t tstepA = 2 * hstepA, tstepB = 2 * hstepB;
    const unsigned ldsw = (unsigned)wid * 1024u;
    const int aoff = lds_byte(wr * 64 + fr, fq * 8), boff = lds_byte(wc * 32 + fr, fq * 8);
#define PG8_SA(b, h) (((b) * 2 + (h)) * HTB)
#define PG8_SB(b, h) ((4 + (b) * 2 + (h)) * HTB)
#ifndef PG8_B_AUX
#define PG8_B_AUX 0
#endif
#define PG8_STAGE_X(bufoff, gbase, voff, AUX) do { _Pragma("unroll") for (int _i = 0; _i < 2; ++_i) \
        __builtin_amdgcn_global_load_lds((const unsigned*)((const char*)(gbase) + (voff)[_i]), (LAS unsigned*)(lds + (bufoff) + ldsw + _i * 8192), 16, 0, AUX); } while (0)
#define PG8_STAGE(bufoff, gbase, voff) PG8_STAGE_X(bufoff, gbase, voff, 0)
#define PG8_STAGEB(bufoff, gbase, voff) PG8_STAGE_X(bufoff, gbase, voff, PG8_B_AUX)
#define PG8_LDA(dst, b, h) do { _Pragma("unroll") for (int m = 0; m < 4; ++m) _Pragma("unroll") for (int k = 0; k < 2; ++k) dst[m][k] = *(const LAS bf16x8*)(lds + PG8_SA(b, h) + aoff + m * 2048 + k * 1024); } while (0)
#define PG8_LDB(dst, b, h) do { _Pragma("unroll") for (int n = 0; n < 2; ++n) _Pragma("unroll") for (int k = 0; k < 2; ++k) dst[n][k] = *(const LAS bf16x8*)(lds + PG8_SB(b, h) + boff + n * 2048 + k * 1024); } while (0)
#define PG8_MMA(ai, bj, At, Bt) do { __builtin_amdgcn_s_setprio(1); _Pragma("unroll") for (int m = 0; m < 4; ++m) _Pragma("unroll") for (int n = 0; n < 2; ++n) _Pragma("unroll") for (int k = 0; k < 2; ++k) \
        acc[ai][bj][m][n] = __builtin_amdgcn_mfma_f32_16x16x32_bf16(Bt[n][k], At[m][k], acc[ai][bj][m][n], 0, 0, 0); __builtin_amdgcn_s_setprio(0); } while (0)
#define PG8_WAIT_V(n) asm volatile("s_waitcnt vmcnt(" #n ")" ::: "memory")
#define PG8_WAIT_L(n) asm volatile("s_waitcnt lgkmcnt(" #n ")" ::: "memory")
#define PG8_BAR __builtin_amdgcn_s_barrier()
#define PG8_SCHED __builtin_amdgcn_sched_barrier(0)
    Unit cur, nxt; int ui = 0;
    if (!S.next(0, cur)) return;
    f32x4 acc[2][2][4][2];
#pragma unroll
    for (int a = 0; a < 2; ++a)
#pragma unroll
        for (int b = 0; b < 2; ++b)
#pragma unroll
            for (int m = 0; m < 4; ++m)
#pragma unroll
                for (int n = 0; n < 2; ++n) acc[a][b][m][n] = (f32x4){0.f, 0.f, 0.f, 0.f};
    bf16x8 At[4][2], B0[2][2], B1[2][2];
    const char* cA = (const char*)g.A + (size_t)cur.pm * tstepA + (size_t)cur.g * K * 2; const char* cB = (const char*)g.Bt + (size_t)cur.pn * tstepB + (size_t)cur.g * K * 2;
#if PG8_SP2
    PG8_STAGEB(PG8_SB(0, 0), cB, voffB); PG8_STAGEB(PG8_SB(0, 1), cB + hstepB, voffB); PG8_STAGE(PG8_SA(0, 0), cA, voffA); PG8_STAGE(PG8_SA(0, 1), cA + hstepA, voffA);
    if (wr == 1) PG8_BAR;
    PG8_WAIT_V(2); PG8_BAR;
    PG8_STAGEB(PG8_SB(1, 0), cB + kstep, voffB); PG8_STAGE(PG8_SA(1, 0), cA + kstep, voffA); PG8_STAGEB(PG8_SB(1, 1), cB + hstepB + kstep, voffB);
    PG8_WAIT_V(6); PG8_BAR;
#else
    PG8_STAGEB(PG8_SB(0, 0), cB, voffB); PG8_STAGE(PG8_SA(0, 0), cA, voffA); PG8_STAGEB(PG8_SB(0, 1), cB + hstepB, voffB); PG8_STAGE(PG8_SA(0, 1), cA + hstepA, voffA);
    if (wr == 1) PG8_BAR;
    PG8_WAIT_V(4); PG8_BAR;
    PG8_STAGEB(PG8_SB(1, 0), cB + kstep, voffB); PG8_STAGE(PG8_SA(1, 0), cA + kstep, voffA); PG8_STAGEB(PG8_SB(1, 1), cB + hstepB + kstep, voffB);
    PG8_WAIT_V(6); PG8_BAR;
#endif
    for (;;) {
        const bool has_next = S.next(ui + 1, nxt);
        const char* nA = has_next ? (const char*)g.A + (size_t)nxt.pm * tstepA + (size_t)nxt.g * K * 2 : cA; const char* nB = has_next ? (const char*)g.Bt + (size_t)nxt.pn * tstepB + (size_t)nxt.g * K * 2 : cB;
        for (int t = 0; t < nt; t += 2) {
            const bool last = (t == nt - 2);
            const char* a1 = cA + (size_t)(t + 1) * kstep;
            const char* a2 = last ? nA : cA + (size_t)(t + 2) * kstep; const char* b2 = last ? nB : cB + (size_t)(t + 2) * kstep;
            const char* a3 = a2 + kstep; const char* b3 = b2 + kstep;
#if PG8_SP2
            PG8_LDB(B0, 0, 0); PG8_LDB(B1, 0, 1); PG8_SCHED; PG8_LDA(At, 0, 0); PG8_STAGE(PG8_SA(1, 1), a1 + hstepA, voffA);
            PG8_WAIT_V(8); PG8_WAIT_L(0); PG8_BAR; PG8_MMA(0, 0, At, B0); PG8_MMA(0, 1, At, B1); PG8_BAR; PG8_SCHED;
            PG8_LDA(At, 0, 1); PG8_STAGEB(PG8_SB(0, 0), b2, voffB); PG8_STAGEB(PG8_SB(0, 1), b2 + hstepB, voffB); PG8_STAGE(PG8_SA(0, 0), a2, voffA);
            PG8_WAIT_V(8); PG8_WAIT_L(0); PG8_BAR; PG8_MMA(1, 0, At, B0); PG8_MMA(1, 1, At, B1); PG8_BAR; PG8_SCHED;
            PG8_LDB(B0, 1, 0); PG8_LDB(B1, 1, 1); PG8_SCHED; PG8_LDA(At, 1, 0); PG8_STAGE(PG8_SA(0, 1), a2 + hstepA, voffA);
            PG8_WAIT_V(8); PG8_WAIT_L(0); PG8_BAR; PG8_MMA(0, 0, At, B0); PG8_MMA(0, 1, At, B1); PG8_BAR; PG8_SCHED;
            PG8_LDA(At, 1, 1); PG8_STAGEB(PG8_SB(1, 0), b3, voffB); PG8_STAGEB(PG8_SB(1, 1), b3 + hstepB, voffB); PG8_STAGE(PG8_SA(1, 0), a3, voffA);
            PG8_WAIT_V(8); PG8_WAIT_L(0); PG8_BAR; PG8_MMA(1, 0, At, B0); PG8_MMA(1, 1, At, B1); PG8_BAR; PG8_SCHED;
        #else
            PG8_LDB(B0, 0, 0); PG8_SCHED; PG8_LDA(At, 0, 0); PG8_STAGE(PG8_SA(1, 1), a1 + hstepA, voffA);
            PG8_WAIT_L(8); PG8_BAR; PG8_WAIT_L(0); PG8_MMA(0, 0, At, B0); PG8_BAR; PG8_SCHED;
            PG8_LDB(B1, 0, 1); PG8_STAGEB(PG8_SB(0, 0), b2, voffB);
            PG8_BAR; PG8_WAIT_L(0); PG8_MMA(0, 1, At, B1); PG8_BAR;
            PG8_LDA(At, 0, 1); PG8_STAGE(PG8_SA(0, 0), a2, voffA);
            PG8_BAR; PG8_WAIT_L(0); PG8_MMA(1, 0, At, B0); PG8_BAR; PG8_SCHED;
            PG8_STAGEB(PG8_SB(0, 1), b2 + hstepB, voffB);
            PG8_WAIT_V(6); PG8_BAR; PG8_MMA(1, 1, At, B1); PG8_BAR;
            PG8_LDB(B0, 1, 0); PG8_SCHED; PG8_LDA(At, 1, 0); PG8_STAGE(PG8_SA(0, 1), a2 + hstepA, voffA);
            PG8_WAIT_L(8); PG8_BAR; PG8_WAIT_L(0); PG8_MMA(0, 0, At, B0); PG8_BAR; PG8_SCHED;
            PG8_LDB(B1, 1, 1); PG8_STAGEB(PG8_SB(1, 0), b3, voffB);
            PG8_BAR; PG8_WAIT_L(0); PG8_MMA(0, 1, At, B1); PG8_BAR;
            PG8_LDA(At, 1, 1); PG8_STAGE(PG8_SA(1, 0), a3, voffA);
            PG8_BAR; PG8_WAIT_L(0); PG8_MMA(1, 0, At, B0); PG8_BAR; PG8_SCHED;
            PG8_STAGEB(PG8_SB(1, 1), b3 + hstepB, voffB);
            PG8_WAIT_V(6); PG8_BAR; PG8_MMA(1, 1, At, B1); PG8_BAR;
#endif
        }
        if (wr == 0) PG8_BAR;
        E(acc, cur, wr, wc, fr, fq);
        if (!has_next) break;
        if (!Epi::CHAIN || nxt.g == 0) {
#pragma unroll
        for (int a = 0; a < 2; ++a)
#pragma unroll
            for (int b = 0; b < 2; ++b)
#pragma unroll
                for (int m = 0; m < 4; ++m)
#pragma unroll
                    for (int n = 0; n < 2; ++n) acc[a][b][m][n] = (f32x4){0.f, 0.f, 0.f, 0.f};
        }
        cur = nxt; cA = nA; cB = nB; ++ui;
        if (wr == 1) PG8_BAR;
    }
    PG8_WAIT_V(0);
    PG8_BAR;
#undef PG8_SA
#undef PG8_SB
#undef PG8_STAGE
#undef PG8_STAGEB
#undef PG8_STAGE_X
#undef PG8_LDA
#undef PG8_LDB
#undef PG8_MMA
#undef PG8_WAIT_V
#undef PG8_WAIT_L
#undef PG8_BAR
#undef PG8_SCHED
}
}

struct Frame {
    lds_u8* lds;
    int G, bid;
    unsigned char* ws;
};
__device__ __forceinline__ const float* in_ptr(int k) { asm volatile("" : "+s"(k)); return ((const float* const __attribute__((address_space(4)))*)__builtin_amdgcn_kernarg_segment_ptr())[k]; }
__device__ __forceinline__ float* out_ptr() { int k = 18; asm volatile("" : "+s"(k)); return ((float* const __attribute__((address_space(4)))*)__builtin_amdgcn_kernarg_segment_ptr())[k]; }
struct Args { const float* in[18]; float* out; unsigned char* ws; };

#define PHASE_TID() int tid = threadIdx.x; asm volatile("" : "+v"(tid)); const int lane = tid & 63; const int wave = __builtin_amdgcn_readfirstlane(tid >> 6); (void)lane; (void)wave
__device__ __forceinline__ bf16x8 frag_row(const lds_u8* tile, int pitch, int r0, int k0, int lane) {
    return *(const LAS bf16x8*)(tile + (r0 + (lane & 15)) * pitch + (k0 + (lane >> 4) * 8) * 2);
}
#ifndef TR_NAIVE
#define TR_NAIVE 0
#endif
__device__ __forceinline__ bf16x8 frag_tr(const lds_u8* tile, int pitch, int k0, int n0, int lane) {
#if TR_NAIVE
    bf16x8 f;
#pragma unroll
    for (int j = 0; j < 8; ++j) f[j] = *(const LAS short*)(tile + (k0 + 8 * (lane >> 4) + j) * pitch + (n0 + (lane & 15)) * 2);
    return f;
#else
    const int g = lane >> 4, i = lane & 15, q = i >> 2, p = i & 3;
    const lds_u8* a = tile + (k0 + 8 * g + q) * pitch + (n0 + 4 * p) * 2;
    const bf16x4 lo = __builtin_amdgcn_ds_read_tr16_b64_v4i16((LAS bf16x4*)a);
    const bf16x4 hi = __builtin_amdgcn_ds_read_tr16_b64_v4i16((LAS bf16x4*)(a + 4 * pitch));
    bf16x8 f; f[0] = lo[0]; f[1] = lo[1]; f[2] = lo[2]; f[3] = lo[3]; f[4] = hi[0]; f[5] = hi[1]; f[6] = hi[2]; f[7] = hi[3];
    return f;
#endif
}
template <bool A_TR, bool B_TR>
__device__ __forceinline__ void mm128(f32x4 (&acc)[2][4], const lds_u8* At, const lds_u8* Bt, int wave, int lane) {
    const int rb = (wave >> 1) * 32, cb = (wave & 1) * 64;
#pragma unroll
    for (int mi = 0; mi < 2; ++mi)
#pragma unroll
        for (int ni = 0; ni < 4; ++ni) acc[mi][ni] = (f32x4){0.f, 0.f, 0.f, 0.f};
#pragma unroll
    for (int kk = 0; kk < 4; ++kk) {
        bf16x8 a[2], b[4];
#pragma unroll
        for (int mi = 0; mi < 2; ++mi) a[mi] = A_TR ? frag_tr(At, TP, kk * 32, rb + mi * 16, lane) : frag_row(At, TP, rb + mi * 16, kk * 32, lane);
#pragma unroll
        for (int ni = 0; ni < 4; ++ni) b[ni] = B_TR ? frag_tr(Bt, TP, kk * 32, cb + ni * 16, lane) : frag_row(Bt, TP, cb + ni * 16, kk * 32, lane);
#pragma unroll
        for (int mi = 0; mi < 2; ++mi)
#pragma unroll
            for (int ni = 0; ni < 4; ++ni) acc[mi][ni] = __builtin_amdgcn_mfma_f32_16x16x32_bf16(a[mi], b[ni], acc[mi][ni], 0, 0, 0);
    }
}
__device__ __forceinline__ void acc_to_stage(const f32x4 (&acc)[2][4], LAS float* st, int wave, int lane) {
    const int rb = (wave >> 1) * 32 + 4 * (lane >> 4), cb = (wave & 1) * 64 + (lane & 15);
#pragma unroll
    for (int mi = 0; mi < 2; ++mi)
#pragma unroll
        for (int ni = 0; ni < 4; ++ni)
#pragma unroll
            for (int r = 0; r < 4; ++r) st[(rb + mi * 16 + r) * SP + cb + ni * 16] = acc[mi][ni][r];
}
__device__ __forceinline__ void tile_g2l(lds_u8* dst, const bf16_t* src, size_t gp, int tid) {
#pragma unroll
    for (int p = 0; p < 4; ++p) { const int row = p * 32 + (tid >> 4), cc = (tid & 15) * 8;
        *(LAS u32x4*)(dst + row * TP + cc * 2) = *(const u32x4*)(src + (size_t)row * gp + cc); }
}

__device__ __forceinline__ void tr_load(float (&v)[64], const float* src, size_t ldn, int lane) {
#pragma unroll
    for (int i = 0; i < 64; ++i) v[i] = src[(size_t)i * ldn + lane];
}
__device__ __forceinline__ void tr_finish(const float (&v)[64], bf16_t* dst, size_t dp, float scale, LAS float* scr, int lane) {
#pragma unroll
    for (int i = 0; i < 64; ++i) scr[i * 65 + lane] = v[i] * scale;
    LDS_WAIT(); asm volatile("" ::: "memory");
    const int c = lane & 7;
#pragma unroll
    for (int j = 0; j < 8; ++j) { const int n = (lane >> 3) + 8 * j; const LAS float* s = scr + (8 * c) * 65 + n;
        u32x4 o; o.x = pk2(s[0 * 65], s[1 * 65]); o.y = pk2(s[2 * 65], s[3 * 65]); o.z = pk2(s[4 * 65], s[5 * 65]); o.w = pk2(s[6 * 65], s[7 * 65]);
        *(u32x4*)(dst + (size_t)n * dp + 8 * c) = o; }
    LDS_WAIT(); asm volatile("" ::: "memory");
}
__device__ __forceinline__ void tr_item(const float* src, size_t ldn, bf16_t* dst, size_t dp, float scale, LAS float* scr, int lane) {
    float v[64]; tr_load(v, src, ldn, lane); tr_finish(v, dst, dp, scale, scr, lane);
}
template <class Setup>
__device__ __forceinline__ void tr_loop(int first, int step, int count, size_t ldn, size_t dp, LAS float* scr, int lane, const Setup& setup) {
    float va[64], vb[64];
    const float* sa; const float* sb; bf16_t* da; bf16_t* db; float ca = 1.f, cb = 1.f;
    int it = first;
    if (it < count) { setup(it, sa, da, ca); tr_load(va, sa, ldn, lane); }
    for (; it < count; it += 2 * step) {
        const int it2 = it + step, it3 = it2 + step;
        if (it2 < count) { setup(it2, sb, db, cb); tr_load(vb, sb, ldn, lane); }
        tr_finish(va, da, dp, ca, scr, lane);
        if (it3 < count) { setup(it3, sa, da, ca); tr_load(va, sa, ldn, lane); }
        if (it2 < count) tr_finish(vb, db, dp, cb, scr, lane);
    }
}
__device__ __forceinline__ void p0_prologue(Frame& F, int l0, int l1, int parts) {
    PHASE_TID();
    LAS float* scr = (LAS float*)(F.lds + wave * 16640);
    const int gw = F.bid * 8 + wave, NGW = F.G * 8;
    const float* w_in = in_ptr(3); const float* w_branch = in_ptr(16); const float* w_out = in_ptr(17); const float* rgw = in_ptr(12);
    bf16_t* WIN = (bf16_t*)(F.ws + WS_WIN); bf16_t* WBR = (bf16_t*)(F.ws + WS_WBR); bf16_t* WOUT = (bf16_t*)(F.ws + WS_WOUT); bf16_t* RWT = (bf16_t*)(F.ws + WS_RWT);
    if (parts & 1) {
    constexpr int I_IN = 64 * 480;
    tr_loop(l0 * I_IN + gw, NGW, l1 * I_IN, PROJ_W, DM, scr, lane, [&](int it, const float*& src_, bf16_t*& dst_, float& sc_) {
        const int l = it / I_IN, r = it % I_IN, kb = r / 480, nb = r % 480, n0 = nb * 64;
        int ns, act = 0;
        if (n0 < C_OZ) ns = n0;
        else if (n0 >= C_G) { const int t = (n0 - C_G) >> 6, b = t & 3;
            const int g = 2 * (b >> 1) + ((lane >> 2) & 1), d = 64 * (t >> 2) + 16 * (2 * (b & 1) + (lane >> 5)) + 4 * ((lane >> 3) & 3) + (lane & 3);
            ns = 14352 + g * DM + d - lane; act = 1; }
        else if (n0 >= C_VG && n0 < C_BZ) { ns = n0 < C_XC ? 6160 + (n0 - C_VG) : (n0 < C_ZC ? 8208 + (n0 - C_XC) : 9232 + (n0 - C_ZC)); act = n0 >= C_ZC; }
        else { const int base = n0 < C_UZ ? C_OZ : (n0 < C_VG ? C_UZ : (n0 < C_CX ? C_BZ : C_CX)); const int sa = base == C_OZ ? 3072 : (base == C_UZ ? 5136 : (base == C_BZ ? 10256 : 11280)), sb = base == C_OZ ? 4096 : (base == C_UZ ? 7184 : (base == C_BZ ? 13328 : 12304));
            const int w = (n0 - base) & 255, hf = w >> 7; ns = (hf ? sb : sa) + ((n0 - base) >> 8) * 128 + (w & 127);
            act = base == C_OZ ? 1 : ((base == C_UZ || base == C_BZ) ? hf : 0); }
        const float sc = (n0 >= C_K && n0 < C_V) ? 0.08838834764831845f : (act ? -1.4426950408889634f : 1.0f);
        src_ = w_in + ((size_t)l * DM + kb * 64) * PROJ_W + ns; dst_ = WIN + ((size_t)l * NP + n0) * DM + kb * 64; sc_ = sc;
    });
    for (int it = l0 * 64 + gw; it < l1 * 64; it += NGW) {
        const int ln = it >> 3, r = it & 7, kb = r >> 2, nb = r & 3;
        tr_item(rgw + ((size_t)ln * 128 + kb * 64) * 256 + nb * 64, 256, RWT + ((size_t)ln * 256 + nb * 64) * 128 + kb * 64, 128, 1.0f, scr, lane);
    }
    }
    if (parts & 2) {
    constexpr int I_BR = 16 * 64;
    tr_loop(l0 * 4 * I_BR + gw, NGW, l1 * 4 * I_BR, DM, DM, scr, lane, [&](int it, const float*& src_, bf16_t*& dst_, float& sc_) {
        const int lg = it / I_BR, r = it % I_BR, l = lg >> 2, g = lg & 3, kb = r / 64, nb = r % 64;
        src_ = w_branch + ((size_t)lg * BW + kb * 64) * DM + nb * 64; dst_ = WBR + ((size_t)l * DM + nb * 64) * DM + g * BW + kb * 64; sc_ = 1.0f;
    });
    constexpr int I_O = 64 * 64;
    tr_loop(l0 * I_O + gw, NGW, l1 * I_O, DM, DM, scr, lane, [&](int it, const float*& src_, bf16_t*& dst_, float& sc_) {
        const int l = it / I_O, r = it % I_O, kb = r / 64, nb = r % 64;
        src_ = w_out + ((size_t)l * DM + kb * 64) * DM + nb * 64; dst_ = WOUT + ((size_t)l * DM + nb * 64) * DM + kb * 64; sc_ = 1.0f;
    });
    }
    if (l0 != 0 || !(parts & 1)) return;
    const int gt = F.bid * 512 + tid, NGT = F.G * 512;
    bf16_t* GWT = (bf16_t*)(F.ws + WS_GWT); const float* gws = in_ptr(8);
    { float* SPL = (float*)(F.ws + WS_SPL); const float* ap = in_ptr(14);
      for (int i = gt; i < DEPTH * BW; i += NGT) { const float av = ap[i]; SPL[i] = -8.0f * ((av > 0.f) ? log1pf(expf(-av)) : (-av + log1pf(expf(av)))); } }
    for (int i = gt; i < DEPTH * 8 * 128 * 128; i += NGT) { const int s = i & 127, t = (i >> 7) & 127;
        GWT[i] = (bf16_t)f2bf(s <= t ? gws[i] : 0.f); }
}

__device__ __forceinline__ void norm_phase(Frame& F, int l) {
    PHASE_TID();
    const bool has_next = l < DEPTH;
    const float* x0 = in_ptr(0);
    bf16_t* H = (bf16_t*)(F.ws + WS_H); float* GATES = (float*)(F.ws + WS_GATES);
    constexpr int WGP = 8208;
    LAS float* sPart = (LAS float*)(F.lds + 16 * WGP);
    __syncthreads();
    if (has_next) {
        const float* wg = in_ptr(3) + (size_t)l * DM * PROJ_W + 5120;
        for (int k = tid; k < DM; k += 512) { const f32x4* p = (const f32x4*)(wg + (size_t)k * PROJ_W);
#pragma unroll
            for (int q = 0; q < 4; ++q) { const f32x4 w = p[q];
#pragma unroll
                for (int j = 0; j < 4; ++j) *(LAS unsigned short*)(F.lds + (q * 4 + j) * WGP + k * 2) = (unsigned short)f2bf(w[j]); } }
    }
    for (int blk = F.bid; blk < SEQ / 32; blk += F.G) {
        for (int ri = 0; ri < 4; ++ri) {
            const int row = blk * 32 + wave * 4 + ri;
            f32x4 v[16];
            if (l < 2) {
                const f32x4* xp = (const f32x4*)(x0 + (size_t)row * DM) + lane;
#pragma unroll
                for (int j = 0; j < 16; ++j) v[j] = xp[64 * j];
            } else {
                const u32x2* rp = (const u32x2*)(F.ws + WS_XR + (size_t)row * DM * 2) + lane;
#pragma unroll
                for (int j = 0; j < 16; ++j) { const u32x2 o = rp[64 * j];
                    v[j][0] = __uint_as_float(o.x << 16); v[j][1] = __uint_as_float(o.x & 0xffff0000u); v[j][2] = __uint_as_float(o.y << 16); v[j][3] = __uint_as_float(o.y & 0xffff0000u); }
            }
            for (int pl = (l < 2 ? 0 : l - 1); pl < l; ++pl) {
                const float* SS = (const float*)(F.ws + (pl == 0 ? WS_SS : WS_SS1));
                const float rstd_o = 1.0f / sqrtf(wave_sum(SS[(size_t)row * 64 + lane]) * (1.0f / DM) + EPS);
                const u32x2* op = (const u32x2*)(F.ws + WS_OUT + (size_t)pl * OUT_L + (size_t)row * DM * 2) + lane; const f32x4* pw = (const f32x4*)(in_ptr(2) + (size_t)pl * DM) + lane;
#pragma unroll
                for (int j = 0; j < 16; ++j) { const u32x2 o = op[64 * j]; const f32x4 w = pw[64 * j];
                    v[j][0] += __uint_as_float(o.x << 16) * rstd_o * w[0]; v[j][1] += __uint_as_float(o.x & 0xffff0000u) * rstd_o * w[1];
                    v[j][2] += __uint_as_float(o.y << 16) * rstd_o * w[2]; v[j][3] += __uint_as_float(o.y & 0xffff0000u) * rstd_o * w[3]; }
            }
            if (!has_next) {
                f32x4* xo = (f32x4*)(out_ptr() + (size_t)row * DM) + lane;
#pragma unroll
                for (int j = 0; j < 16; ++j) xo[64 * j] = v[j];
            } else {
                float s2 = 0.f;
#pragma unroll
                for (int j = 0; j < 16; ++j) s2 += (v[j][0] * v[j][0] + v[j][1] * v[j][1]) + (v[j][2] * v[j][2] + v[j][3] * v[j][3]);
                const float rstd = 1.0f / sqrtf(wave_sum(s2) * (1.0f / DM) + EPS);
                const f32x4* pw = (const f32x4*)(in_ptr(1) + (size_t)l * DM) + lane;
                u32x2* ho = (u32x2*)(H + (size_t)row * DM) + lane;
                if (l >= 1) { u32x2* ro = (u32x2*)(F.ws + WS_XR + (size_t)row * DM * 2) + lane;
#pragma unroll
                    for (int j = 0; j < 16; ++j) { u32x2 w; w.x = pk2(v[j][0], v[j][1]); w.y = pk2(v[j][2], v[j][3]); ro[64 * j] = w; } }
#pragma unroll
                for (int j = 0; j < 16; ++j) { const f32x4 hv = v[j] * rstd * pw[64 * j]; u32x2 w; w.x = pk2(hv[0], hv[1]); w.y = pk2(hv[2], hv[3]); ho[64 * j] = w; }
            }
        }
        if (has_next) {
            asm volatile("s_waitcnt vmcnt(0)" ::: "memory");
            __syncthreads();
            const int mt = wave >> 2, kq = wave & 3;
            const bf16_t* hA = H + (size_t)(blk * 32 + mt * 16 + (lane & 15)) * DM + kq * 1024 + 8 * (lane >> 4);
            const lds_u8* wB = F.lds + (lane & 15) * WGP + (kq * 1024 + 8 * (lane >> 4)) * 2;
            f32x4 acc = (f32x4){0.f, 0.f, 0.f, 0.f};
#pragma unroll
            for (int hb = 0; hb < 2; ++hb) { bf16x8 a[16];
#pragma unroll
                for (int kk = 0; kk < 16; ++kk) a[kk] = *(const bf16x8*)(hA + (hb * 16 + kk) * 32);
#pragma unroll
                for (int kk = 0; kk < 16; ++kk) { const bf16x8 bw = *(const LAS bf16x8*)(wB + (hb * 16 + kk) * 64); acc = __builtin_amdgcn_mfma_f32_16x16x32_bf16(a[kk], bw, acc, 0, 0, 0); } }
            *(LAS f32x4*)(sPart + (wave * 64 + lane) * 4) = acc;
            __syncthreads();
            { const int row = tid >> 4, n = tid & 15, m2 = row >> 4, r = row & 15, ln = (r >> 2) * 16 + n, rg = r & 3; float sum = 0.f;
#pragma unroll
              for (int q = 0; q < 4; ++q) sum += sPart[((m2 * 4 + q) * 64 + ln) * 4 + rg];
              GATES[(size_t)(blk * 32 + row) * 16 + n] = sum + in_ptr(4)[(size_t)l * 16 + n]; }
        }
    }
    __syncthreads();
}

__device__ __forceinline__ float log_sigmoidf_(float x) { return x >= 0.f ? -log1pf(expf(-x)) : x - log1pf(expf(x)); }

struct SconvRegs { u32x4 cxv[4][3], bzv[4]; };
__device__ __forceinline__ void sconv_load(Frame& F, int unit, int tid, SconvRegs& R) {
    const int c = unit >> 3, n = unit & 7, t0 = c * LCH;
    const bf16_t* PROJ = (const bf16_t*)(F.ws + WS_PROJ);
    const int chg = n * 128 + (tid & 15) * 8;
#pragma unroll
    for (int p = 0; p < 4; ++p) { const int t = t0 + p * 32 + (tid >> 4);
#pragma unroll
        for (int k = 0; k < 3; ++k) { const int ts = t - 2 + k, tc = ts < 0 ? 0 : ts; R.cxv[p][k] = *(const u32x4*)(PROJ + (size_t)tc * NP + C_CX + chg); }
        R.bzv[p] = *(const u32x4*)(PROJ + (size_t)t * NP + C_BZ + chg); }
}
__device__ __forceinline__ void sconv_finish(Frame& F, int unit, int l, int tid, const SconvRegs& R) {
    const int c = unit >> 3, n = unit & 7, t0 = c * LCH;
    const float* sw = in_ptr(15) + (size_t)l * 3 * BW; bf16_t* YS = (bf16_t*)(F.ws + WS_YS);
    const int chg = n * 128 + (tid & 15) * 8;
    float w[3][8];
#pragma unroll
    for (int k = 0; k < 3; ++k) { const f32x4 a = *(const f32x4*)(sw + k * BW + chg), b = *(const f32x4*)(sw + k * BW + chg + 4);
#pragma unroll
        for (int j = 0; j < 4; ++j) { w[k][j] = a[j]; w[k][4 + j] = b[j]; } }
#pragma unroll
    for (int p = 0; p < 4; ++p) { const int t = t0 + p * 32 + (tid >> 4);
        float acc[8];
#pragma unroll
        for (int j = 0; j < 8; ++j) acc[j] = 0.f;
#pragma unroll
        for (int k = 0; k < 3; ++k) { const float msk = (t - 2 + k >= 0) ? 1.0f : 0.0f; float cx[8]; unpack8(R.cxv[p][k], cx);
#pragma unroll
            for (int j = 0; j < 8; ++j) acc[j] += (msk * w[k][j]) * cx[j]; }
        float bz[8]; unpack8(R.bzv[p], bz);
        float y[8];
#pragma unroll
        for (int j = 0; j < 8; ++j) y[j] = bz[j] * acc[j];
        *(u32x4*)(YS + (size_t)t * DM + 3 * BW + chg) = pack8(y); }
}

__device__ __forceinline__ void mlstm_c1(Frame& F, int unit, int l) {
    PHASE_TID();
    SconvRegs SR; sconv_load(F, unit, tid, SR);
    const int h = unit >> 6, c = unit & 63, t0 = c * LCH;
    const bf16_t* PROJ = (const bf16_t*)(F.ws + WS_PROJ); const float* GATES = (const float*)(F.ws + WS_GATES);
    lds_u8* Vs = F.lds; lds_u8* Ks = F.lds + TILE_B;
    LAS float* sA = (LAS float*)(F.lds + SCAL_OFF); LAS float* sX = sA + 128; LAS float* sP = sA + 256;
    u32x4 vreg[4], kreg[4];
#pragma unroll
    for (int p = 0; p < 4; ++p) { const int row = p * 32 + (tid >> 4), cc = (tid & 15) * 8; const size_t gro = (size_t)(t0 + row) * NP + h * 128 + cc;
        vreg[p] = *(const u32x4*)(PROJ + gro + C_V); kreg[p] = *(const u32x4*)(PROJ + gro + C_K); }
    __syncthreads();
    if (wave == 0) {
        const int t = 2 * lane;
        const float lf0 = log_sigmoidf_(GATES[(size_t)(t0 + t) * 16 + 8 + h]), lf1 = log_sigmoidf_(GATES[(size_t)(t0 + t + 1) * 16 + 8 + h]);
        const float i0 = GATES[(size_t)(t0 + t) * 16 + h], i1 = GATES[(size_t)(t0 + t + 1) * 16 + h];
        float sc = lf0 + lf1;
#pragma unroll
        for (int d = 1; d < 64; d <<= 1) { const float o = __shfl_up(sc, d); if (lane >= d) sc += o; }
        const float b1 = sc, b0 = sc - lf1, a0 = i0 - b0, a1 = i1 - b1;
        float mx = fmaxf(a0, a1);
#pragma unroll
        for (int d = 1; d < 64; d <<= 1) { const float o = __shfl_up(mx, d); if (lane >= d) mx = fmaxf(mx, o); }
        float mprev = __shfl_up(mx, 1); if (lane == 0) mprev = -3.0e38f;
        const float u0 = fmaxf(mprev, a0), u1 = mx;
        float* TB = (float*)(F.ws + WS_TB) + (size_t)h * SEQ + t0; float* TA = TB + (size_t)8 * SEQ; float* TU = TA + (size_t)8 * SEQ;
        *(f32x2*)(TB + t) = (f32x2){b0, b1}; *(f32x2*)(TA + t) = (f32x2){a0, a1}; *(f32x2*)(TU + t) = (f32x2){u0, u1};
        sA[t] = a0; sA[t + 1] = a1;
        if (lane == 63) { sX[0] = u1; float* BL = (float*)(F.ws + WS_DN + 256 * 1024); float* ML = BL + 1024; BL[h * 64 + c] = b1; ML[h * 64 + c] = b1 + u1; }
    }
    __syncthreads();
    const float umax = sX[0];
#pragma unroll
    for (int p = 0; p < 4; ++p) { const int row = p * 32 + (tid >> 4), cc = (tid & 15) * 8;
        *(LAS u32x4*)(Vs + row * TP + cc * 2) = vreg[p];
        float kf[8]; unpack8(kreg[p], kf); const float w = __expf(sA[row] - umax);
#pragma unroll
        for (int j = 0; j < 8; ++j) kf[j] *= w;
        *(LAS u32x4*)(Ks + row * TP + cc * 2) = pack8(kf); }
    __syncthreads();
    f32x4 acc[2][4];
    mm128<true, true>(acc, Ks, Vs, wave, lane);
    sconv_finish(F, unit, l, tid, SR);
    float* DC = (float*)(F.ws + WS_DC) + (size_t)unit * 16384;
    { const int db = (wave >> 1) * 32 + 4 * (lane >> 4), eb = (wave & 1) * 64 + (lane & 15);
#pragma unroll
      for (int mi = 0; mi < 2; ++mi)
#pragma unroll
        for (int ni = 0; ni < 4; ++ni) *(f32x4*)(DC + (eb + ni * 16) * 128 + db + mi * 16) = acc[mi][ni]; }
    { const int d = tid & 127, sg = tid >> 7; float sum = 0.f;
#pragma unroll 8
      for (int t = 0; t < 32; ++t) sum += bf2f(*(const LAS unsigned short*)(Ks + (sg * 32 + t) * TP + d * 2));
      sP[sg * 128 + d] = sum; }
    __syncthreads();
    if (tid < 128) ((float*)(F.ws + WS_DN))[(size_t)unit * 128 + tid] = (sP[tid] + sP[128 + tid]) + (sP[256 + tid] + sP[384 + tid]);
}

__device__ __forceinline__ void mlstm_c2(Frame& F) {
    PHASE_TID();
    const float* DC = (const float*)(F.ws + WS_DC); const float* DN = (const float*)(F.ws + WS_DN);
    const float* BL = (const float*)(F.ws + WS_DN + 256 * 1024); const float* ML = BL + 1024;
    bf16_t* CST = (bf16_t*)(F.ws + WS_CST); float* NST = (float*)(F.ws + WS_NST); float* MST = (float*)(F.ws + WS_NST + 256 * 1024);
    for (int e = F.bid * 512 + tid; e < 8 * 16384; e += F.G * 512) {
        const int h = e >> 14, idx = e & 16383; const bool hasn = idx < 128;
        float m = 0.f, C = 0.f, n = 0.f;
        for (int c0 = 0; c0 < NCH; c0 += 32) {
            float dc[32], dn[32];
#pragma unroll
            for (int q = 0; q < 32; ++q) { const size_t u = (size_t)h * 64 + c0 + q; dc[q] = DC[u * 16384 + idx]; dn[q] = hasn ? DN[u * 128 + idx] : 0.f; }
#pragma unroll
            for (int q = 0; q < 32; ++q) { const size_t u = (size_t)h * 64 + c0 + q;
                CST[u * 16384 + idx] = (bf16_t)f2bf(C);
                if (hasn) NST[u * 128 + idx] = n;
                if (idx == 0) MST[u] = m;
                const float bl = BL[u], ml = ML[u];
                const float mn = fmaxf(bl + m, ml), dec = __expf(bl + m - mn), sc = __expf(ml - mn);
                C = dec * C + sc * dc[q]; n = dec * n + sc * dn[q]; m = mn; }
        }
    }
}

__device__ __forceinline__ void mlstm_c3(Frame& F, int unit, int l) {
    PHASE_TID();
    const int h = unit >> 6, c = unit & 63, t0 = c * LCH;
    const bf16_t* PROJ = (const bf16_t*)(F.ws + WS_PROJ);
    lds_u8* Ks = F.lds; lds_u8* Vs = F.lds + TILE_B; lds_u8* Cs = F.lds + 2 * TILE_B; lds_u8* Ps = F.lds + 3 * TILE_B;
    LAS float* sA = (LAS float*)(F.lds + SCAL_OFF); LAS float* sM = sA + 128; LAS float* sWi = sA + 256; LAS float* sEm = sA + 384; LAS float* sN = sA + 512;
    const int rw = wave * 16, fr = lane & 15, fq = lane >> 4;
    bf16x8 qf[4];
    { const bf16_t* qrow = PROJ + (size_t)(t0 + rw + fr) * NP + C_Q + h * 128 + 8 * fq;
#pragma unroll
      for (int kk = 0; kk < 4; ++kk) qf[kk] = *(const bf16x8*)(qrow + kk * 32); }
    u32x4 ozreg[4]; f32x4 nwv[4][2];
    { const float* nw = in_ptr(5) + (size_t)l * BW + h * 128;
#pragma unroll
      for (int it = 0; it < 4; ++it) { const int idx = lane + 64 * (it & 1), row = idx >> 3, e = 64 * (it >> 1) + 8 * (idx & 7); const size_t gro = (size_t)(t0 + rw + row) * NP + h * 128 + e;
        ozreg[it] = *(const u32x4*)(PROJ + gro + C_OZ); nwv[it][0] = *(const f32x4*)(nw + e); nwv[it][1] = *(const f32x4*)(nw + e + 4); } }
    __syncthreads();
    tile_g2l(Ks, PROJ + (size_t)t0 * NP + C_K + h * 128, NP, tid);
    tile_g2l(Vs, PROJ + (size_t)t0 * NP + C_V + h * 128, NP, tid);
    tile_g2l(Cs, (const bf16_t*)(F.ws + WS_CST) + (size_t)unit * 16384, 128, tid);
    if (tid < 128) {
        const float* TB = (const float*)(F.ws + WS_TB) + (size_t)h * SEQ + t0; const float* TA = TB + (size_t)8 * SEQ; const float* TU = TA + (size_t)8 * SEQ;
        const float mc = ((const float*)(F.ws + WS_NST + 256 * 1024))[unit];
        const float b = TB[tid], a = TA[tid], u = TU[tid], M = fmaxf(mc, u);
        sA[tid] = a; sM[tid] = M; sWi[tid] = __expf(mc - M); sEm[tid] = __expf(-(b + M));
        sN[tid] = ((const float*)(F.ws + WS_NST))[(size_t)unit * 128 + tid];
    }
    __syncthreads();
    f32x4 accS[8];
#pragma unroll
    for (int ni = 0; ni < 8; ++ni) { accS[ni] = (f32x4){0.f, 0.f, 0.f, 0.f};
        if (ni <= wave) {
#pragma unroll
            for (int kk = 0; kk < 4; ++kk) accS[ni] = __builtin_amdgcn_mfma_f32_16x16x32_bf16(qf[kk], frag_row(Ks, TP, 16 * ni, kk * 32, lane), accS[ni], 0, 0, 0); } }
    float denr[4], Mr[4];
#pragma unroll
    for (int r = 0; r < 4; ++r) { const int t = rw + 4 * fq + r; Mr[r] = sM[t]; float ds = 0.f;
#pragma unroll
        for (int ni = 0; ni < 8; ++ni) { const int sx = 16 * ni + fr; float pv = 0.f;
            if (ni <= wave) { const float e = __expf(sA[sx] - Mr[r]); pv = (sx <= t) ? accS[ni][r] * e : 0.f; }
            ds += pv; *(LAS unsigned short*)(Ps + t * TP + sx * 2) = (unsigned short)f2bf(pv); }
        ds += __shfl_xor(ds, 1); ds += __shfl_xor(ds, 2); ds += __shfl_xor(ds, 4); ds += __shfl_xor(ds, 8); denr[r] = ds; }
    f32x4 accB[8];
#pragma unroll
    for (int ni = 0; ni < 8; ++ni) { accB[ni] = (f32x4){0.f, 0.f, 0.f, 0.f};
#pragma unroll
        for (int kk = 0; kk < 4; ++kk) accB[ni] = __builtin_amdgcn_mfma_f32_16x16x32_bf16(qf[kk], frag_row(Cs, TP, 16 * ni, kk * 32, lane), accB[ni], 0, 0, 0); }
    float nqv = 0.f;
#pragma unroll
    for (int kk = 0; kk < 4; ++kk) { const f32x4 n0 = *(const LAS f32x4*)(sN + kk * 32 + 8 * fq), n1 = *(const LAS f32x4*)(sN + kk * 32 + 8 * fq + 4);
#pragma unroll
        for (int j = 0; j < 4; ++j) { nqv += bf2f((unsigned short)qf[kk][j]) * n0[j]; nqv += bf2f((unsigned short)qf[kk][4 + j]) * n1[j]; } }
    nqv += __shfl_xor(nqv, 16); nqv += __shfl_xor(nqv, 32);
    asm volatile("s_waitcnt lgkmcnt(0)" ::: "memory");
    f32x4 accA[8];
#pragma unroll
    for (int ni = 0; ni < 8; ++ni) accA[ni] = (f32x4){0.f, 0.f, 0.f, 0.f};
    const int kmax = (rw + 15) >> 5;
#pragma unroll
    for (int kk = 0; kk < 4; ++kk) { if (kk <= kmax) { const bf16x8 pa = frag_row(Ps, TP, rw, kk * 32, lane);
#pragma unroll
        for (int ni = 0; ni < 8; ++ni) accA[ni] = __builtin_amdgcn_mfma_f32_16x16x32_bf16(pa, frag_tr(Vs, TP, kk * 32, 16 * ni, lane), accA[ni], 0, 0, 0); } }
#pragma unroll
    for (int r = 0; r < 4; ++r) { const int t = rw + 4 * fq + r; const float wi = sWi[t]; const float nqr = __shfl(nqv, 4 * fq + r);
        const float den = denr[r] + wi * nqr; const float inv = 1.0f / fmaxf(fabsf(den), sEm[t]); float ss = 0.f;
#pragma unroll
        for (int ni = 0; ni < 8; ++ni) { const float hv = (accA[ni][r] + wi * accB[ni][r]) * inv; accA[ni][r] = hv; ss += hv * hv; }
        ss += __shfl_xor(ss, 1); ss += __shfl_xor(ss, 2); ss += __shfl_xor(ss, 4); ss += __shfl_xor(ss, 8);
        const float rinv = 1.0f / sqrtf(ss * (1.0f / 128.0f) + EPS);
#pragma unroll
        for (int ni = 0; ni < 8; ++ni) accA[ni][r] *= rinv; }
    bf16_t* YS = (bf16_t*)(F.ws + WS_YS);
    LAS float* stw = (LAS float*)(Ps + rw * TP);
#pragma unroll
    for (int hf = 0; hf < 2; ++hf) {
        asm volatile("s_waitcnt lgkmcnt(0)" ::: "memory");
#pragma unroll
        for (int q = 0; q < 4; ++q)
#pragma unroll
            for (int r = 0; r < 4; ++r) stw[(4 * fq + r) * 68 + 16 * q + fr] = accA[4 * hf + q][r];
        asm volatile("s_waitcnt lgkmcnt(0)" ::: "memory");
#pragma unroll
        for (int i = 0; i < 2; ++i) { const int it = 2 * hf + i, idx = lane + 64 * i, row = idx >> 3, e = 64 * hf + 8 * (idx & 7);
            const f32x4 x0 = *(const LAS f32x4*)(stw + row * 68 + 8 * (idx & 7)), x1 = *(const LAS f32x4*)(stw + row * 68 + 8 * (idx & 7) + 4);
            float oz[8]; unpack8(ozreg[it], oz);
            float y[8];
#pragma unroll
            for (int j = 0; j < 4; ++j) { y[j] = x0[j] * nwv[it][0][j] * oz[j]; y[4 + j] = x1[j] * nwv[it][1][j] * oz[4 + j]; }
            *(u32x4*)(YS + (size_t)(t0 + rw + row) * DM + h * 128 + e) = pack8(y); }
    }
}

__device__ __forceinline__ void gmlp_stats(Frame& F) {
    PHASE_TID();
    const bf16_t* PROJ = (const bf16_t*)(F.ws + WS_PROJ); f32x2* LNS = (f32x2*)(F.ws + WS_LNS);
    for (int r0 = (F.bid * 8 + wave) * 4; r0 < SEQ; r0 += F.G * 8 * 4) {
        u32x4 v[4][2];
#pragma unroll
        for (int i = 0; i < 4; ++i) { const bf16_t* p = PROJ + (size_t)(r0 + i) * NP + C_VG + lane * 16; v[i][0] = *(const u32x4*)p; v[i][1] = *(const u32x4*)(p + 8); }
#pragma unroll
        for (int i = 0; i < 4; ++i) { float f[8], g8[8]; unpack8(v[i][0], f); unpack8(v[i][1], g8); float sm = 0.f, s2 = 0.f;
#pragma unroll
            for (int j = 0; j < 8; ++j) { sm += f[j] + g8[j]; s2 += f[j] * f[j] + g8[j] * g8[j]; }
            sm = wave_sum(sm); s2 = wave_sum(s2);
            const float mean = sm * (1.0f / 1024.0f), var = fmaxf(s2 * (1.0f / 1024.0f) - mean * mean, 0.f);
            if (lane == 0) LNS[r0 + i] = (f32x2){mean, 1.0f / sqrtf(var + EPS)}; }
    }
}

__device__ __forceinline__ void gmlp_unit(Frame& F, int unit, int l) {
    PHASE_TID();
    const int c = (unit & 7) + 8 * (unit >> 6), g = (unit >> 3) & 7, t0 = c * LCH;
    const bf16_t* PROJ = (const bf16_t*)(F.ws + WS_PROJ);
    lds_u8* Ws = F.lds; lds_u8* Vn = F.lds + TILE_B; LAS float* st = (LAS float*)(F.lds + 2 * TILE_B);
    u32x4 uzreg[4], vgreg[4], wreg[4];
    { const bf16_t* GW = (const bf16_t*)(F.ws + WS_GWT) + ((size_t)l * 8 + g) * 16384;
#pragma unroll
      for (int p = 0; p < 4; ++p) { const int row = p * 32 + (tid >> 4), cc = (tid & 15) * 8; const size_t gro = (size_t)(t0 + row) * NP + g * 128 + cc;
        uzreg[p] = *(const u32x4*)(PROJ + gro + C_UZ); vgreg[p] = *(const u32x4*)(PROJ + gro + C_VG); wreg[p] = *(const u32x4*)(GW + (size_t)row * 128 + cc); } }
    f32x2 mr[4];
#pragma unroll
    for (int p = 0; p < 4; ++p) mr[p] = ((const f32x2*)(F.ws + WS_LNS))[t0 + p * 32 + (tid >> 4)];
    __syncthreads();
    const float* lnw = in_ptr(6) + (size_t)l * BW + g * 128; const float* lnb = in_ptr(7) + (size_t)l * BW + g * 128;
#pragma unroll
    for (int p = 0; p < 4; ++p) { const int row = p * 32 + (tid >> 4), cc = (tid & 15) * 8;
        *(LAS u32x4*)(Ws + row * TP + cc * 2) = wreg[p];
        float f[8]; unpack8(vgreg[p], f); const float mean = mr[p][0], rstd = mr[p][1];
#pragma unroll
        for (int j = 0; j < 8; ++j) f[j] = (f[j] - mean) * rstd * lnw[cc + j] + lnb[cc + j];
        *(LAS u32x4*)(Vn + row * TP + cc * 2) = pack8(f); }
    __syncthreads();
    f32x4 acc[2][4];
    mm128<false, true>(acc, Ws, Vn, wave, lane);
    acc_to_stage(acc, st, wave, lane);
    __syncthreads();
    const float* bs = in_ptr(9) + ((size_t)l * 8 + g) * 128; bf16_t* YS = (bf16_t*)(F.ws + WS_YS);
#pragma unroll
    for (int p = 0; p < 4; ++p) { const int t = p * 32 + (tid >> 4), cc = (tid & 15) * 8;
        float uz[8]; unpack8(uzreg[p], uz); const float b = bs[t];
        float y[8];
#pragma unroll
        for (int j = 0; j < 8; ++j) y[j] = uz[j] * (st[t * SP + cc + j] + b);
        *(u32x4*)(YS + (size_t)(t0 + t) * DM + BW + g * 128 + cc) = pack8(y); }
}

__device__ __forceinline__ void rglru_c1(Frame& F, int unit, int l) {
    PHASE_TID();
    const int c = unit >> 3, n = unit & 7, t0 = c * LCH;
    const bf16_t* PROJ = (const bf16_t*)(F.ws + WS_PROJ);
    lds_u8* Xs = F.lds; LAS float* XF = (LAS float*)(F.lds + TILE_B);
    const int cc = (tid & 15) * 8, chg = n * 128 + cc, trow = tid >> 4;
    const int fr = lane & 15, fq = lane >> 4, chw = 16 * wave + fr;
    u32x4 xr[4][4];
#pragma unroll
    for (int p = 0; p < 4; ++p)
#pragma unroll
        for (int k = 0; k < 4; ++k) { const int ts = t0 + p * 32 + trow - 3 + k, tc = ts < 0 ? 0 : ts; xr[p][k] = *(const u32x4*)(PROJ + (size_t)tc * NP + C_XC + chg); }
    bf16x8 wrf[4], wif[4];
    { const bf16_t* RWT = (const bf16_t*)(F.ws + WS_RWT) + ((size_t)l * 8 + n) * 256 * 128 + (size_t)chw * 128 + 8 * fq;
#pragma unroll
      for (int kk = 0; kk < 4; ++kk) { wrf[kk] = *(const bf16x8*)(RWT + kk * 32); wif[kk] = *(const bf16x8*)(RWT + 128 * 128 + kk * 32); } }
    float cwv[4][8], cbv[8];
    { const float* cw = in_ptr(10) + (size_t)l * 4 * BW + chg; const float* cb = in_ptr(11) + (size_t)l * BW + chg;
#pragma unroll
      for (int k = 0; k < 4; ++k) { const f32x4 a4 = *(const f32x4*)(cw + k * BW), b4 = *(const f32x4*)(cw + k * BW + 4);
#pragma unroll
        for (int j = 0; j < 4; ++j) { cwv[k][j] = a4[j]; cwv[k][4 + j] = b4[j]; } }
      const f32x4 c0 = *(const f32x4*)cb, c1 = *(const f32x4*)(cb + 4);
#pragma unroll
      for (int j = 0; j < 4; ++j) { cbv[j] = c0[j]; cbv[4 + j] = c1[j]; } }
    const float spl = ((const float*)(F.ws + WS_SPL))[(size_t)l * BW + n * 128 + chw];
    const float brc = in_ptr(13)[(size_t)l * 2 * BW + n * 128 + chw], bic = in_ptr(13)[(size_t)l * 2 * BW + BW + n * 128 + chw];
    __syncthreads();
#pragma unroll
    for (int p = 0; p < 4; ++p) { const int t = p * 32 + trow; float xv[8];
#pragma unroll
        for (int j = 0; j < 8; ++j) xv[j] = cbv[j];
#pragma unroll
        for (int k = 0; k < 4; ++k) { const float msk = (t0 + t - 3 + k >= 0) ? 1.0f : 0.0f; float f[8]; unpack8(xr[p][k], f);
#pragma unroll
            for (int j = 0; j < 8; ++j) xv[j] += (msk * cwv[k][j]) * f[j]; }
        *(LAS u32x4*)(Xs + t * TP + cc * 2) = pack8(xv);
        *(LAS f32x4*)(XF + t * SP + cc) = (f32x4){xv[0], xv[1], xv[2], xv[3]}; *(LAS f32x4*)(XF + t * SP + cc + 4) = (f32x4){xv[4], xv[5], xv[6], xv[7]}; }
    __syncthreads();
    f32x4 gr[8], gi[8];
#pragma unroll
    for (int mi = 0; mi < 8; ++mi) { gr[mi] = (f32x4){0.f, 0.f, 0.f, 0.f}; gi[mi] = (f32x4){0.f, 0.f, 0.f, 0.f};
#pragma unroll
        for (int kk = 0; kk < 4; ++kk) { const bf16x8 xa = frag_row(Xs, TP, 16 * mi, kk * 32, lane);
            gr[mi] = __builtin_amdgcn_mfma_f32_16x16x32_bf16(xa, wrf[kk], gr[mi], 0, 0, 0);
            gi[mi] = __builtin_amdgcn_mfma_f32_16x16x32_bf16(xa, wif[kk], gi[mi], 0, 0, 0); } }
#pragma unroll
    for (int mi = 0; mi < 8; ++mi)
#pragma unroll
        for (int r = 0; r < 4; ++r) { const int t = 16 * mi + 4 * fq + r; const float xvv = XF[t * SP + chw];
            const float rg = sigmoidf_(gr[mi][r] + brc), ig = sigmoidf_(gi[mi][r] + bic);
            const float la = rg * spl; const float av = __builtin_amdgcn_exp2f(1.44269504f * la);
            const float x2 = 2.0f * la;
            const float ser = -x2 * (1.0f + x2 * (0.5f + x2 * (0.16666667f + x2 * (0.041666668f + x2 * (0.0083333338f + x2 * 0.0013888889f)))));
            const float em = (x2 > -0.5f) ? ser : (1.0f - av * av);
            float mult = __builtin_amdgcn_sqrtf(fmaxf(em, 0.f)); if (t0 + t == 0) mult = 1.0f;
            gr[mi][r] = av; gi[mi][r] = mult * ig * xvv; }
    float Ac = 1.f, hc = 0.f;
#pragma unroll
    for (int mi = 0; mi < 8; ++mi) {
        float al[4], hl[4]; float A = 1.f, hh = 0.f;
#pragma unroll
        for (int r = 0; r < 4; ++r) { hh = gr[mi][r] * hh + gi[mi][r]; A *= gr[mi][r]; al[r] = A; hl[r] = hh; }
        float Ai = A, hi = hh;
        { const float Ap = __shfl_up(Ai, 16), hp = __shfl_up(hi, 16); if (fq >= 1) { hi = Ai * hp + hi; Ai = Ai * Ap; } }
        { const float Ap = __shfl_up(Ai, 32), hp = __shfl_up(hi, 32); if (fq >= 2) { hi = Ai * hp + hi; Ai = Ai * Ap; } }
        float Ae = __shfl_up(Ai, 16), he = __shfl_up(hi, 16); if (fq == 0) { Ae = 1.f; he = 0.f; }
        const float At = __shfl(Ai, fr + 48), ht = __shfl(hi, fr + 48);
        const float As = Ac * Ae, hs = Ae * hc + he;
#pragma unroll
        for (int r = 0; r < 4; ++r) { gr[mi][r] = al[r] * hs + hl[r]; gi[mi][r] = As * al[r]; }
        hc = At * hc + ht; Ac = Ac * At;
    }
    if (fq == 0) { float* AP = (float*)(F.ws + WS_APROD); AP[c * BW + n * 128 + chw] = Ac; AP[65536 + c * BW + n * 128 + chw] = hc; }
    bf16_t* HL = (bf16_t*)(F.ws + WS_HLOC); bf16_t* AC = (bf16_t*)(F.ws + WS_ACUM);
#pragma unroll
    for (int which = 0; which < 2; ++which) {
        asm volatile("s_waitcnt lgkmcnt(0)" ::: "memory");
#pragma unroll
        for (int mi = 0; mi < 8; ++mi)
#pragma unroll
            for (int r = 0; r < 4; ++r) XF[(16 * mi + 4 * fq + r) * SP + chw] = which == 0 ? gr[mi][r] : gi[mi][r];
        asm volatile("s_waitcnt lgkmcnt(0)" ::: "memory");
#pragma unroll
        for (int i = 0; i < 4; ++i) { const int idx = lane + 64 * i, row = idx >> 1, c8 = idx & 1;
            const f32x4 x0 = *(const LAS f32x4*)(XF + row * SP + 16 * wave + 8 * c8), x1 = *(const LAS f32x4*)(XF + row * SP + 16 * wave + 8 * c8 + 4);
            float v8[8];
#pragma unroll
            for (int j = 0; j < 4; ++j) { v8[j] = x0[j]; v8[4 + j] = x1[j]; }
            *(u32x4*)((which == 0 ? HL : AC) + (size_t)(t0 + row) * BW + n * 128 + 16 * wave + 8 * c8) = pack8(v8); }
    }
}
__device__ __forceinline__ void rglru_c3(Frame& F, int unit) {
    PHASE_TID();
    const int c = unit >> 3, n = unit & 7, t0 = c * LCH;
    const bf16_t* PROJ = (const bf16_t*)(F.ws + WS_PROJ);
    const bf16_t* HL = (const bf16_t*)(F.ws + WS_HLOC); const bf16_t* AC = (const bf16_t*)(F.ws + WS_ACUM); bf16_t* YS = (bf16_t*)(F.ws + WS_YS);
    LAS float* sCarry = (LAS float*)(F.lds + SCAL_OFF);
    u32x4 hv[4], av[4], zv[4];
#pragma unroll
    for (int p = 0; p < 4; ++p) { const int t = p * 32 + (tid >> 4), cc = (tid & 15) * 8; const size_t o = (size_t)(t0 + t) * BW + n * 128 + cc;
        hv[p] = *(const u32x4*)(HL + o); av[p] = *(const u32x4*)(AC + o); zv[p] = *(const u32x4*)(PROJ + (size_t)(t0 + t) * NP + C_ZC + n * 128 + cc); }
    __syncthreads();
    if (tid < 128) { const float* AP = (const float*)(F.ws + WS_APROD) + n * 128 + tid; float carry = 0.f;
        int cp = 0;
        for (; cp + 8 <= c; cp += 8) { float a[8], hl[8];
#pragma unroll
            for (int j = 0; j < 8; ++j) { a[j] = AP[(cp + j) * BW]; hl[j] = AP[65536 + (cp + j) * BW]; }
#pragma unroll
            for (int j = 0; j < 8; ++j) carry = a[j] * carry + hl[j]; }
        for (; cp < c; ++cp) carry = AP[cp * BW] * carry + AP[65536 + cp * BW];
        sCarry[tid] = carry; }
    __syncthreads();
#pragma unroll
    for (int p = 0; p < 4; ++p) { const int t = p * 32 + (tid >> 4), cc = (tid & 15) * 8;
        float hf[8], af[8], zf[8]; unpack8(hv[p], hf); unpack8(av[p], af); unpack8(zv[p], zf);
        float y[8];
#pragma unroll
        for (int j = 0; j < 8; ++j) y[j] = (hf[j] + af[j] * sCarry[cc + j]) * zf[j];
        *(u32x4*)(YS + (size_t)(t0 + t) * DM + 2 * BW + n * 128 + cc) = pack8(y); }
}
__global__ void __launch_bounds__(512, 2) hybrid_fwd(Args args) {
    extern __shared__ __attribute__((aligned(16))) unsigned char lds_raw[];
    Frame F;
    F.lds = (lds_u8*)lds_raw;
    F.G = gridDim.x; F.bid = blockIdx.x;
    F.ws = args.ws;
    volatile LAS unsigned* MISC = (volatile LAS unsigned*)(F.lds + MISC_OFF);
    if (threadIdx.x < 64) MISC[threadIdx.x] = 0u;
    __syncthreads();
    XcdBarrier bar = xcd_barrier_post((unsigned*)(F.ws + WS_CTL) + CW_BAR, MISC + 8);
#define GRID_BAR() xcd_barrier(bar)

    for (int l = 0; l <= DEPTH; ++l) {
        for (int rep = 0; rep < REP_NORM; ++rep) norm_phase(F, l);
        if (l == DEPTH) break;
        if (l == 0) { for (int rep = 0; rep < REP_P0; ++rep) p0_prologue(F, 0, 1, 1); }
        GRID_BAR();
        for (int rep = 0; rep < REP_B; ++rep) {
            pg8::Gemm g{(const bf16_t*)(F.ws + WS_H), (const bf16_t*)(F.ws + WS_WIN + (size_t)l * WIN_L), DM, DM, DM};
            pg8::StaticOrder S; S.init(SEQ, NP, F.G, F.bid, 1);
            pg8::EpiProj E{(bf16_t*)(F.ws + WS_PROJ), F.lds + pg8::STAGE_BYTES, 0};
            const int cp = (l == 0 && rep == 0) ? 2 * (int)(xb_xcc_id() & 7u) : (1 << 30);
            for (int part = 0; part < 2; ++part) {
                if (part == 1) { if (l != 0 || rep != 0) break; __syncthreads(); p0_prologue(F, 0, 1, 2); p0_prologue(F, 1, DEPTH, 3); __syncthreads(); }
                S.i0 = part == 0 ? 0 : cp; S.i1 = part == 0 ? cp : (1 << 30);
                pg8::gemm_phase<pg8::EpiProj>(F.lds, g, S, E, STAG_B);
            }
            GRID_BAR();
        }
        for (int rep = 0; rep < REP_MIX; ++rep) {
        for (int r1 = 0; r1 < REP_C1; ++r1) {
        for (int q = 0; q < REP_U1; ++q) for (int u = F.bid; u < 512; u += F.G) mlstm_c1(F, u, l);
        for (int q = 0; q < REP_U2; ++q) for (int u = F.bid; u < 512; u += F.G) rglru_c1(F, u, l);
        gmlp_stats(F);
        GRID_BAR();
        }
        for (int r2 = 0; r2 < REP_C2; ++r2) {
        mlstm_c2(F);
        for (int q = 0; q < REP_U3; ++q) for (int u = F.bid; u < 512; u += F.G) gmlp_unit(F, u, l);
        GRID_BAR();
        }
        for (int r3 = 0; r3 < REP_C3; ++r3) {
        for (int u = F.bid; u < 512; u += F.G) mlstm_c3(F, u, l);
        for (int u = F.bid; u < 512; u += F.G) rglru_c3(F, u);
        GRID_BAR();
        }
        }
        for (int rep = 0; rep < REP_D; ++rep) {
            pg8::Gemm g{(const bf16_t*)(F.ws + WS_YS), (const bf16_t*)(F.ws + WS_WBR + (size_t)l * WSQ_L), DM, DM, BW};
            pg8::StaticOrder S; S.init(SEQ, DM, F.G, F.bid, 4);
            pg8::EpiMerge E{(const bf16_t*)(F.ws + WS_PROJ) + C_G, (bf16_t*)(F.ws + WS_MERGED), 0};
            __syncthreads();
            pg8::gemm_phase<pg8::EpiMerge>(F.lds, g, S, E, STAG_D);
            GRID_BAR();
        }
        for (int rep = 0; rep < REP_E; ++rep) {
            pg8::Gemm g{(const bf16_t*)(F.ws + WS_MERGED), (const bf16_t*)(F.ws + WS_WOUT + (size_t)l * WSQ_L), DM, DM, DM};
            pg8::StaticOrder S; S.init(SEQ, DM, F.G, F.bid, 1);
            pg8::EpiOut E{(bf16_t*)(F.ws + WS_OUT + (size_t)l * OUT_L), (float*)(F.ws + (l == 0 ? WS_SS : WS_SS1))};
            pg8::gemm_phase<pg8::EpiOut>(F.lds, g, S, E, STAG_E);
            GRID_BAR();
        }
    }
#if PROBE_TAIL >= 10
    {
        GRID_BAR();
        pg8::Gemm g{(const bf16_t*)(F.ws + WS_YS), (const bf16_t*)(F.ws + WS_WBR + WSQ_L), DM, DM, BW};
        pg8::StaticOrder S; S.init(SEQ, DM, F.G, F.bid, 4);
        pg8::EpiMerge E{(const bf16_t*)(F.ws + WS_PROJ) + C_G, (bf16_t*)(F.ws + WS_MERGED), PROBE_TAIL - 10};
        pg8::gemm_phase<pg8::EpiMerge>(F.lds, g, S, E, 0);
    }
#elif PROBE_TAIL
    {
        GRID_BAR();
        pg8::Gemm g{(const bf16_t*)(F.ws + WS_H), (const bf16_t*)(F.ws + WS_WIN + WIN_L), DM, DM, DM};
        pg8::StaticOrder S; S.init(SEQ, NP, F.G, F.bid, 1); S.same = (PROBE_TAIL == 1);
        pg8::EpiProj E{(bf16_t*)(F.ws + WS_PROJ), F.lds + pg8::STAGE_BYTES, PROBE_TAIL == 2 ? 1 : (PROBE_TAIL >= 3 ? PROBE_TAIL : 0)};
        pg8::gemm_phase<pg8::EpiProj>(F.lds, g, S, E, STAG_B);
    }
#endif
}

extern "C" void kernel_launch(void* const* d_in, const int* in_sizes, int n_in, void* d_out, int out_size, void* d_ws, size_t ws_size, hipStream_t stream) {
    static int grid = 0;
    if (grid == 0) {
        if (n_in != 18 || in_sizes[0] != SEQ * DM || out_size != SEQ * DM || ws_size < WS_END) {
            fprintf(stderr, "kernel_launch: unexpected problem: n_in %d in0 %d out %d ws %zu (need %zu)\n", n_in, n_in > 0 ? in_sizes[0] : -1, out_size, ws_size, (size_t)WS_END); grid = -1; return; }
        int dev = 0, cus = 0, per_cu = 0;
        if (hipGetDevice(&dev) != hipSuccess || hipDeviceGetAttribute(&cus, hipDeviceAttributeMultiprocessorCount, dev) != hipSuccess) { fprintf(stderr, "kernel_launch: device query failed\n"); grid = -1; return; }
        if (hipFuncSetAttribute((const void*)hybrid_fwd, hipFuncAttributeMaxDynamicSharedMemorySize, LDS_BYTES) != hipSuccess) { fprintf(stderr, "kernel_launch: hipFuncSetAttribute failed\n"); grid = -1; return; }
        if (hipOccupancyMaxActiveBlocksPerMultiprocessor(&per_cu, (const void*)hybrid_fwd, 512, LDS_BYTES) != hipSuccess || per_cu < 1)
            fprintf(stderr, "kernel_launch: note: occupancy query reports %d workgroups per CU\n", per_cu);
        (void)hipGetLastError();
        grid = cus;
    }
    if (grid < 0) return;
    if (hipMemsetAsync((char*)d_ws + WS_CTL, 0, CTL_ZERO_BYTES, stream) != hipSuccess) { fprintf(stderr, "kernel_launch: memset failed\n"); return; }
    Args a{};
    for (int i = 0; i < 18; ++i) a.in[i] = (const float*)d_in[i];
    a.out = (float*)d_out; a.ws = (unsigned char*)d_ws;
    hipLaunchKernelGGL(hybrid_fwd, dim3(grid), dim3(512), LDS_BYTES, stream, a);
    const hipError_t le = hipPeekAtLastError();
    if (le != hipSuccess) fprintf(stderr, "kernel_launch: launch failed: %s\n", hipGetErrorName(le));
}
```

```cpp
#include <hip/hip_runtime.h>
#include <cstdio>
#include <cstdint>

#define LAS __attribute__((address_space(3)))
#define GAS __attribute__((address_space(1)))
typedef unsigned short bf16_t;
typedef short bf16x8 __attribute__((ext_vector_type(8)));
typedef short bf16x4 __attribute__((ext_vector_type(4)));
typedef float f32x4 __attribute__((ext_vector_type(4)));
typedef float f32x2 __attribute__((ext_vector_type(2)));
typedef unsigned u32x4 __attribute__((ext_vector_type(4)));
typedef unsigned u32x2 __attribute__((ext_vector_type(2)));
typedef LAS unsigned char lds_u8;
typedef __bf16 bf16x2_t __attribute__((ext_vector_type(2)));

#ifndef REP_P0
#define REP_P0 1
#endif
#ifndef REP_NORM
#define REP_NORM 1
#endif
#ifndef REP_B
#define REP_B 1
#endif
#ifndef REP_MIX
#define REP_MIX 1
#endif
#ifndef REP_U1
#define REP_U1 1
#endif
#ifndef REP_U2
#define REP_U2 1
#endif
#ifndef REP_U3
#define REP_U3 1
#endif
#ifndef REP_U4
#define REP_U4 1
#endif
#ifndef REP_C1
#define REP_C1 1
#endif
#ifndef REP_C2
#define REP_C2 1
#endif
#ifndef REP_C3
#define REP_C3 1
#endif
#ifndef REP_D
#define REP_D 1
#endif
#ifndef REP_E
#define REP_E 1
#endif
#ifndef PROBE_TAIL
#define PROBE_TAIL 0
#endif
#ifndef STAG_B
#define STAG_B 0u
#endif
#ifndef STAG_D
#define STAG_D 0u
#endif
#ifndef STAG_E
#define STAG_E 0u
#endif
constexpr int DM = 4096, SEQ = 8192, DEPTH = 2, BW = 1024, NHEAD = 8, LCH = 128, NCH = 64;
constexpr int PROJ_W = 30736, NP = 30720;
constexpr int C_Q = 0, C_K = 1024, C_V = 2048, C_OZ = 3072, C_UZ = 5120, C_VG = 7168, C_XC = 8192, C_ZC = 9216, C_BZ = 10240, C_CX = 12288, C_G = 14336;
constexpr float EPS = 1e-6f;

constexpr size_t MiB = 1u << 20;
constexpr size_t WS_CTL = 0, CTL_ZERO_BYTES = 1 * MiB;
constexpr size_t WS_WIN = 16 * MiB;
constexpr size_t WIN_L = (size_t)NP * DM * 2;
constexpr size_t WS_WBR = 496 * MiB;
constexpr size_t WS_WOUT = 560 * MiB;
constexpr size_t WSQ_L = (size_t)DM * DM * 2;
constexpr size_t WS_SPL = 624 * MiB;
constexpr size_t WS_LNS = 624 * MiB + 65536;
constexpr size_t WS_GWT = 625 * MiB;
constexpr size_t WS_RWT = 626 * MiB;
constexpr size_t WS_H = 640 * MiB;
constexpr size_t WS_PROJ = 704 * MiB;
constexpr size_t WS_YS = 1184 * MiB;
constexpr size_t WS_MERGED = 1248 * MiB;
constexpr size_t WS_OUT = 1312 * MiB;
constexpr size_t OUT_L = (size_t)SEQ * DM * 2;
constexpr size_t WS_SS1 = 1440 * MiB;
constexpr size_t WS_SS = 1568 * MiB;
constexpr size_t WS_GATES = 1570 * MiB;
constexpr size_t WS_TB = 1571 * MiB;
constexpr size_t WS_XR = 1696 * MiB;
constexpr size_t WS_DC = 1576 * MiB;
constexpr size_t WS_DN = 1608 * MiB;
constexpr size_t WS_CST = 1610 * MiB;
constexpr size_t WS_NST = 1626 * MiB;
constexpr size_t WS_HLOC = 1628 * MiB;
constexpr size_t WS_ACUM = 1660 * MiB;
constexpr size_t WS_APROD = 1692 * MiB;
constexpr size_t WS_END = 1760 * MiB;
constexpr int CW_BAR = 4096;
constexpr int CW_TCNT = 8192;
constexpr int T0_TILES = 32, SLOT_TILES = 11;

constexpr int LDS_BYTES = 163840;
constexpr int MISC_OFF = LDS_BYTES - 256;
constexpr int TP = 272;
constexpr int TILE_B = 128 * TP;
constexpr int SP = 132;
constexpr int SCAL_OFF = 4 * TILE_B;

__device__ __forceinline__ float bf2f(unsigned short b) { return __uint_as_float(((unsigned)b) << 16); }
__device__ __forceinline__ unsigned f2bf(float f) { unsigned u = __float_as_uint(f); return (u + 0x7fffu + ((u >> 16) & 1u)) >> 16; }
typedef float f32x2_t __attribute__((ext_vector_type(2)));
typedef __bf16 bf16x2_t __attribute__((ext_vector_type(2)));
__device__ __forceinline__ unsigned cvt_pk_bf16(float lo, float hi) { const f32x2_t v = {lo, hi}; const bf16x2_t r = __builtin_convertvector(v, bf16x2_t); return __builtin_bit_cast(unsigned, r); }
__device__ __forceinline__ unsigned pk2(float lo, float hi) { return cvt_pk_bf16(lo, hi); }
__device__ __forceinline__ void unpack8(const u32x4 v, float (&f)[8]) {
    f[0] = __uint_as_float(v.x << 16); f[1] = __uint_as_float(v.x & 0xffff0000u); f[2] = __uint_as_float(v.y << 16); f[3] = __uint_as_float(v.y & 0xffff0000u);
    f[4] = __uint_as_float(v.z << 16); f[5] = __uint_as_float(v.z & 0xffff0000u); f[6] = __uint_as_float(v.w << 16); f[7] = __uint_as_float(v.w & 0xffff0000u);
}
__device__ __forceinline__ u32x4 pack8(const float (&f)[8]) { u32x4 w; w.x = pk2(f[0], f[1]); w.y = pk2(f[2], f[3]); w.z = pk2(f[4], f[5]); w.w = pk2(f[6], f[7]); return w; }
__device__ __forceinline__ float wave_sum(float v) {
#pragma unroll
    for (int o = 1; o < 64; o <<= 1) v += __shfl_xor(v, o);
    return v;
}
__device__ __forceinline__ float sigmoidf_(float x) { return __builtin_amdgcn_rcpf(1.0f + __builtin_amdgcn_exp2f(-1.44269504f * x)); }
#define LDS_WAIT() asm volatile("s_waitcnt lgkmcnt(0)" ::: "memory")
#define VM_WAIT() asm volatile("s_waitcnt vmcnt(0)" ::: "memory")

#define XB_TMO      128
#define XB_XCNT(j)  (256  + 64 * (j))
#define XB_XSUB(j)  (1280 + 64 * (j))
#define XB_XGEN(j)  (2304 + 64 * (j))
#define XB_TOP      3328
#define XB_TOPGEN   3392
#define XCD_BAR_WORDS 3456
#define XB_SPIN_CAP (1u << 18)

__device__ __forceinline__ unsigned xb_ld(unsigned* p)              { return __hip_atomic_load(p, __ATOMIC_RELAXED, __HIP_MEMORY_SCOPE_AGENT); }
__device__ __forceinline__ unsigned xb_add(unsigned* p, unsigned v) { return __hip_atomic_fetch_add(p, v, __ATOMIC_RELAXED, __HIP_MEMORY_SCOPE_AGENT); }
__device__ __forceinline__ unsigned xb_xcc_id() { return (unsigned)__builtin_amdgcn_s_getreg((3 << 11) | 20) & 0xFu; }
#define XB_SPIN(cond, bar) do { unsigned _sp = 0; while (cond) { __builtin_amdgcn_s_sleep(1); \
    if ((++_sp & 255u) == 0u) { if (xb_ld(&(bar)[XB_TMO])) break; if (_sp > XB_SPIN_CAP) { atomicAdd(&(bar)[XB_TMO], 1u); break; } } } } while (0)

struct XcdBarrier { unsigned* bar; unsigned x; volatile LAS unsigned* st; };

__device__ __forceinline__ XcdBarrier xcd_barrier_post(unsigned* bar, volatile LAS unsigned* st) {
    XcdBarrier b; b.bar = bar; b.x = xb_xcc_id(); b.st = st;
    if (threadIdx.x == 0) (void)xb_add(&bar[XB_XCNT(b.x)], 1u);
    return b;
}
__device__ __forceinline__ void xcd_barrier_complete(unsigned* bar, unsigned x, unsigned& nloc, unsigned& nx) {
    const unsigned G = gridDim.x * gridDim.y * gridDim.z;
    unsigned sum, cnt, mine, sp = 0u;
    for (;;) {
        sum = 0u; cnt = 0u; mine = 0u;
#pragma unroll
        for (unsigned j = 0; j < 16; ++j) { const unsigned c = xb_ld(&bar[XB_XCNT(j)]); sum += c; cnt += (c > 0u) ? 1u : 0u; mine = (j == x) ? c : mine; }
        if (sum == G) break;
        __builtin_amdgcn_s_sleep(1);
        if ((++sp & 255u) == 0u) { if (xb_ld(&bar[XB_TMO])) break; if (sp > XB_SPIN_CAP) { atomicAdd(&bar[XB_TMO], 1u); break; } }
    }
    nloc = mine > 0u ? mine : 1u; nx = cnt > 0u ? cnt : 1u;
}
__device__ __forceinline__ void xcd_barrier(const XcdBarrier& b) {
    asm volatile("s_waitcnt vmcnt(0)" ::: "memory");
    __syncthreads();
    if (threadIdx.x == 0) {
        unsigned* bar = b.bar;
        __builtin_amdgcn_s_waitcnt(0);
        unsigned nloc = b.st[0], nx = b.st[1];
        if (nloc == 0u) { xcd_barrier_complete(bar, b.x, nloc, nx); b.st[0] = nloc; b.st[1] = nx; }
        const unsigned old = xb_add(&bar[XB_XSUB(b.x)], 1u);
        const unsigned gen = old / nloc;
        if (old + 1u == (gen + 1u) * nloc) {
            __builtin_amdgcn_fence(__ATOMIC_RELEASE, "agent");
            asm volatile("s_waitcnt vmcnt(0)" ::: "memory");
            const unsigned og = xb_add(&bar[XB_TOP], 1u);
            const unsigned tg = og / nx;
            if (og + 1u == (tg + 1u) * nx) xb_add(&bar[XB_TOPGEN], 1u);
            else XB_SPIN(xb_ld(&bar[XB_TOPGEN]) == tg, bar);
            __builtin_amdgcn_fence(__ATOMIC_ACQUIRE, "agent");
            xb_add(&bar[XB_XGEN(b.x)], 1u);
            asm volatile("s_waitcnt vmcnt(0)" ::: "memory");
        } else {
            XB_SPIN(xb_ld(&bar[XB_XGEN(b.x)]) == gen, bar);
            __builtin_amdgcn_fence(__ATOMIC_ACQUIRE, "agent");
            asm volatile("s_waitcnt vmcnt(0)" ::: "memory");
        }
    }
    __syncthreads();
}

namespace pg8 {
constexpr int BM = 256, BK = 64, HALF = 128, HTB = HALF * BK * 2, STAGE_BYTES = 8 * HTB, NXCD = 8, WGM = 8;
__host__ __device__ __forceinline__ int lds_byte(int r, int c) { const int st = (r >> 4) * 2 + (c >> 5), rr = r & 15, cc = c & 31, ob = rr * 64 + cc * 2; return st * 1024 + (ob ^ (((ob >> 9) & 1) << 5)); }
__host__ __device__ __forceinline__ void stage_rc(int b, int& R, int& C) { const int st = b / 1024, sb = b % 1024, swz = sb ^ (((sb >> 9) & 1) << 5); R = (st >> 1) * 16 + swz / 64; C = (st & 1) * 32 + (swz % 64) / 2; }
__host__ __device__ __forceinline__ int perm32(int rho) { const int n = rho >> 4, i = rho & 15; return 8 * (i >> 2) + 4 * n + (i & 3); }

struct Unit { int pm, pn, g; };
struct Gemm { const bf16_t* A; const bf16_t* Bt; int lda, ldb, K; unsigned* tcnt; unsigned* bar; };

struct StaticOrder {
    int remap8;
    int nM, nN, nwg, G, c, gdiv, same, i0, i1;
    __device__ void init(int M, int N, int G_, int c_, int gdiv_) { nM = M / BM; nN = N / BM; nwg = nM * nN; G = G_; c = c_; gdiv = gdiv_; same = 0; i0 = 0; i1 = 1 << 30; remap8 = 0; }
    __device__ bool next(int ir, Unit& u) const { const int i = ir + i0; if (i >= i1) return false; return at(i, u); }
    __device__ bool at(int i, Unit& u) const {
        const int ti = i / gdiv; u.g = i - ti * gdiv;
        const long L = (long)ti * G + c; if (L >= nwg) return false;
        int wgid = (int)L; { const int q = nwg / NXCD, r = nwg % NXCD, xcd = wgid % NXCD, off = wgid / NXCD; wgid = (xcd < r ? xcd * (q + 1) : r * (q + 1) + (xcd - r) * q) + off; }
        const int nig = WGM * nN, gid = wgid / nig, fm = gid * WGM, gsz = (nM - fm) < WGM ? (nM - fm) : WGM;
        u.pm = fm + ((wgid % nig) % gsz); u.pn = (wgid % nig) / gsz; if (same) { u.pm = 0; u.pn = 0; }
        if (remap8) { const int hi = u.pn >= 60 ? 1 : 0, k = u.pn - 60 * hi; u.pn = 8 * (k >> 2) + 4 * hi + (k & 3); }
        return true;
    }
};


struct EpiProj {
    static constexpr bool PERM = true, CHAIN = false;
    bf16_t* O; lds_u8* xbuf; int skip;
    __device__ __forceinline__ void gate_tile(f32x4 (&acc)[2][2][4][2], const Unit& u, int wr, int wc, int fr, int fq) const {
        const int j = u.pn - 56, row0 = u.pm * BM + wr * 64 + fr, dl0 = 16 * wc + 8 * (fq >> 1);
#pragma unroll
        for (int ai = 0; ai < 2; ++ai)
#pragma unroll
            for (int m = 0; m < 4; ++m) { bf16_t* rowp = O + (size_t)(row0 + ai * HALF + m * 16) * NP + C_G + 64 * j + dl0;
                f32x4 d[4], s[4];
#pragma unroll
                for (int g = 0; g < 4; ++g) {
#pragma unroll
                    for (int q = 0; q < 4; ++q) d[g][q] = 1.0f + __builtin_amdgcn_exp2f(acc[ai][g >> 1][m][g & 1][q]);
#pragma unroll
                    for (int q = 0; q < 4; ++q) s[g][q] = __builtin_amdgcn_rcpf(d[g][q]); }
                u32x2 w[4];
#pragma unroll
                for (int g = 0; g < 4; ++g) { f32x4 v = s[g];
                    if (g < 3) {
#pragma unroll
                        for (int q = 0; q < 4; ++q) v[q] *= fminf(d[g + 1][q], 1e12f); }
                    w[g].x = cvt_pk_bf16(v[0], v[1]); w[g].y = cvt_pk_bf16(v[2], v[3]); }
#pragma unroll
                for (int g = 0; g < 2; ++g) {
                    const auto r0 = __builtin_amdgcn_permlane16_swap(w[g].x, w[g + 2].x, false, false); const auto r1 = __builtin_amdgcn_permlane16_swap(w[g].y, w[g + 2].y, false, false);
                    u32x4 o; o.x = r0[0]; o.y = r1[0]; o.z = r0[1]; o.w = r1[1];
                    *(u32x4*)(rowp + (size_t)(g + 2 * (fq & 1)) * DM) = o; } }
    }
    __device__ __forceinline__ void pair_tile(f32x4 (&acc)[2][2][4][2], const Unit& u, int wr, int wc, int fr, int fq) const {
        const int kind = u.pn < 20 ? 0 : (u.pn < 48 ? 1 : 2);
        const int pb = u.pn < 20 ? 12 : (u.pn < 28 ? 20 : (u.pn < 48 ? 40 : 48));
        const int cbase = (pb == 12 ? C_OZ : (pb == 20 ? C_UZ : (pb == 40 ? C_BZ : C_CX))) + (u.pn - pb) * 128 + wc * 32 + 8 * fq;
        const int row0 = u.pm * BM + wr * 64 + fr;
#pragma unroll
        for (int ai = 0; ai < 2; ++ai)
#pragma unroll
            for (int m = 0; m < 4; ++m) { f32x4 a0 = acc[ai][0][m][0], a1 = acc[ai][0][m][1], b0 = acc[ai][1][m][0], b1 = acc[ai][1][m][1];
                if (kind != 2) { f32x4 e0, e1;
#pragma unroll
                    for (int j = 0; j < 4; ++j) { e0[j] = __builtin_amdgcn_rcpf(1.0f + __builtin_amdgcn_exp2f(b0[j])); e1[j] = __builtin_amdgcn_rcpf(1.0f + __builtin_amdgcn_exp2f(b1[j])); }
                    b0 = b0 * e0 * -0.6931471805599453f; b1 = b1 * e1 * -0.6931471805599453f;
                    if (kind == 0) {
#pragma unroll
                        for (int j = 0; j < 4; ++j) { a0[j] = __builtin_amdgcn_rcpf(1.0f + __builtin_amdgcn_exp2f(a0[j])); a1[j] = __builtin_amdgcn_rcpf(1.0f + __builtin_amdgcn_exp2f(a1[j])); } } }
                a0 = a0 * b0; a1 = a1 * b1;
                u32x4 w; w.x = cvt_pk_bf16(a0[0], a0[1]); w.y = cvt_pk_bf16(a0[2], a0[3]); w.z = cvt_pk_bf16(a1[0], a1[1]); w.w = cvt_pk_bf16(a1[2], a1[3]);
                *(u32x4*)(O + (size_t)(row0 + ai * HALF + m * 16) * NP + cbase) = w; }
    }
    __device__ __forceinline__ void operator()(f32x4 (&acc)[2][2][4][2], const Unit& u, int wr, int wc, int fr, int fq) const {
        if (skip == 1) {
#pragma unroll
            for (int ai = 0; ai < 2; ++ai)
#pragma unroll
                for (int bj = 0; bj < 2; ++bj)
#pragma unroll
                    for (int m = 0; m < 4; ++m) asm volatile("" :: "v"(acc[ai][bj][m][0]), "v"(acc[ai][bj][m][1]));
            return; }
        const int seg = u.pn >> 2;
        if (seg >= 14 && skip == 0) { gate_tile(acc, u, wr, wc, fr, fq); return; }
        if (skip == 0 && ((u.pn >= 12 && u.pn < 28) || (u.pn >= 40 && u.pn < 56))) { pair_tile(acc, u, wr, wc, fr, fq); return; }
        const int mode = (skip == 3 || skip == 5) ? 0 : ((seg >= 14) ? 1 : ((seg == 9) ? 2 : 0));
        const int row0 = u.pm * BM + wr * 64 + fr, col0 = u.pn * BM + wc * 32 + 8 * fq;
#pragma unroll
        for (int ai = 0; ai < 2; ++ai)
#pragma unroll
            for (int m = 0; m < 4; ++m) { bf16_t* rowp = O + (size_t)(row0 + ai * HALF + m * 16) * NP + col0;
                if (skip == 5) rowp = O + (size_t)(u.pm * 120 + u.pn) * 65536 + ((ai * 4 + m) * 2) * 4096 + (wr * 4 + wc) * 512 + (fq * 16 + fr) * 8;
#pragma unroll
                for (int bj = 0; bj < 2; ++bj) { f32x4 v0 = acc[ai][bj][m][0], v1 = acc[ai][bj][m][1];
                    if (mode != 0) {
                        f32x4 e0, e1;
#pragma unroll
                        for (int j = 0; j < 4; ++j) { e0[j] = __builtin_amdgcn_exp2f(v0[j]); e1[j] = __builtin_amdgcn_exp2f(v1[j]); }
#pragma unroll
                        for (int j = 0; j < 4; ++j) { e0[j] = __builtin_amdgcn_rcpf(1.0f + e0[j]); e1[j] = __builtin_amdgcn_rcpf(1.0f + e1[j]); }
                        if (mode == 1) { v0 = e0; v1 = e1; } else { v0 = v0 * e0 * -0.6931471805599453f; v1 = v1 * e1 * -0.6931471805599453f; }
                    }
                    u32x4 w; w.x = cvt_pk_bf16(v0[0], v0[1]); w.y = cvt_pk_bf16(v0[2], v0[3]); w.z = cvt_pk_bf16(v1[0], v1[1]); w.w = cvt_pk_bf16(v1[2], v1[3]);
                    if (skip == 4) asm volatile("" :: "v"(w)); else *(u32x4*)(rowp + (skip == 5 ? bj * 4096 : bj * HALF)) = w; } }
    }
};
struct EpiMerge {
    static constexpr bool PERM = true, CHAIN = true;
    const bf16_t* G; bf16_t* MERGED; int skip;
    __device__ __forceinline__ void operator()(f32x4 (&acc)[2][2][4][2], const Unit& u, int wr, int wc, int fr, int fq) const {
        const int row0 = u.pm * BM + wr * 64 + fr, col0 = u.pn * BM + wc * 32 + 8 * fq;
        const int g = u.g;
        if (skip == 1 && g < 3) return;
#pragma unroll
        for (int ai = 0; ai < 2; ++ai) { u32x4 gw[4][2];
#pragma unroll
            for (int m = 0; m < 4; ++m)
#pragma unroll
                for (int bj = 0; bj < 2; ++bj) gw[m][bj] = *(const u32x4*)(G + (size_t)(row0 + ai * HALF + m * 16) * NP + (size_t)g * DM + col0 + bj * HALF);
#pragma unroll
            for (int m = 0; m < 4; ++m) { const size_t r = (size_t)(row0 + ai * HALF + m * 16);
#pragma unroll
                for (int bj = 0; bj < 2; ++bj) { const int c = col0 + bj * HALF;
                    float gf[8]; unpack8(gw[m][bj], gf);
                    f32x4 v0 = acc[ai][bj][m][0], v1 = acc[ai][bj][m][1];
                    v0[0] *= gf[0]; v0[1] *= gf[1]; v0[2] *= gf[2]; v0[3] *= gf[3]; v1[0] *= gf[4]; v1[1] *= gf[5]; v1[2] *= gf[6]; v1[3] *= gf[7];
                    if (g < 3) { acc[ai][bj][m][0] = v0; acc[ai][bj][m][1] = v1; }
                    else { u32x4 w; w.x = cvt_pk_bf16(v0[0], v0[1]); w.y = cvt_pk_bf16(v0[2], v0[3]); w.z = cvt_pk_bf16(v1[0], v1[1]); w.w = cvt_pk_bf16(v1[2], v1[3]);
                        *(u32x4*)(MERGED + r * DM + c) = w; } } }
            asm volatile("" ::: "memory"); }
    }
};
struct EpiOut {
    static constexpr bool PERM = true, CHAIN = false;
    bf16_t* OUT; float* SS;
    __device__ __forceinline__ void operator()(f32x4 (&acc)[2][2][4][2], const Unit& u, int wr, int wc, int fr, int fq) const {
        const int row0 = u.pm * BM + wr * 64 + fr, col0 = u.pn * BM + wc * 32 + 8 * fq;
#pragma unroll
        for (int ai = 0; ai < 2; ++ai)
#pragma unroll
            for (int m = 0; m < 4; ++m) { const size_t r = (size_t)(row0 + ai * HALF + m * 16); bf16_t* rowp = OUT + r * DM + col0; float q = 0.f;
#pragma unroll
                for (int bj = 0; bj < 2; ++bj) { const f32x4 v0 = acc[ai][bj][m][0], v1 = acc[ai][bj][m][1];
                    q += (v0[0] * v0[0] + v0[1] * v0[1]) + (v0[2] * v0[2] + v0[3] * v0[3]) + (v1[0] * v1[0] + v1[1] * v1[1]) + (v1[2] * v1[2] + v1[3] * v1[3]);
                    u32x4 w; w.x = cvt_pk_bf16(v0[0], v0[1]); w.y = cvt_pk_bf16(v0[2], v0[3]); w.z = cvt_pk_bf16(v1[0], v1[1]); w.w = cvt_pk_bf16(v1[2], v1[3]);
                    *(u32x4*)(rowp + bj * HALF) = w; }
                q += __shfl_xor(q, 16); q += __shfl_xor(q, 32);
                if (fq == 0) SS[r * 64 + u.pn * 4 + wc] = q; }
    }
};

#ifndef PG8_SP2
#define PG8_SP2 1
#endif
template <class Epi>
__device__ __forceinline__ void gemm_phase(lds_u8* lds, const Gemm g, const StaticOrder& S, const Epi& E, unsigned stagger_ticks) {
    if (stagger_ticks) { const unsigned long long t0 = __builtin_amdgcn_s_memrealtime(); const unsigned long long dl = (unsigned long long)(xb_xcc_id() & 7u) * stagger_ticks;
        while (__builtin_amdgcn_s_memrealtime() - t0 < dl) __builtin_amdgcn_s_sleep(8); }
    int tid = threadIdx.x; asm volatile("" : "+v"(tid));
    const int wid = __builtin_amdgcn_readfirstlane(tid >> 6), lane = tid & 63, wr = wid >> 2, wc = wid & 3, fr = lane & 15, fq = lane >> 4;
    const int K = g.K, nt = K / BK;
    unsigned voffA[2], voffB[2];
#pragma unroll
    for (int i = 0; i < 2; ++i) { int R, C; stage_rc(tid * 16 + i * 8192, R, C); const int Rb = Epi::PERM ? ((R & ~31) + perm32(R & 31)) : R;
        voffA[i] = (unsigned)(R * g.lda + C) * 2u; voffB[i] = (unsigned)(Rb * g.ldb + C) * 2u; }
    const size_t kstep = (size_t)(BK * 2);
    const size_t hstepA = (size_t)HALF * g.lda * 2, hstepB = (size_t)HALF * g.ldb * 2;
    const size_t tstepA = 2 * hstepA, tstepB = 2 * hstepB;
    const unsigned ldsw = (unsigned)wid * 1024u;
    const int aoff = lds_byte(wr * 64 + fr, fq * 8), boff = lds_byte(wc * 32 + fr, fq * 8);
#define PG8_SA(b, h) (((b) * 2 + (h)) * HTB)
#define PG8_SB(b, h) ((4 + (b) * 2 + (h)) * HTB)
#ifndef PG8_B_AUX
#define PG8_B_AUX 0
#endif
#define PG8_STAGE_X(bufoff, gbase, voff, AUX) do { _Pragma("unroll") for (int _i = 0; _i < 2; ++_i) \
        __builtin_amdgcn_global_load_lds((const unsigned*)((const char*)(gbase) + (voff)[_i]), (LAS unsigned*)(lds + (bufoff) + ldsw + _i * 8192), 16, 0, AUX); } while (0)
#define PG8_STAGE(bufoff, gbase, voff) PG8_STAGE_X(bufoff, gbase, voff, 0)
#define PG8_STAGEB(bufoff, gbase, voff) PG8_STAGE_X(bufoff, gbase, voff, PG8_B_AUX)
#define PG8_LDA(dst, b, h) do { _Pragma("unroll") for (int m = 0; m < 4; ++m) _Pragma("unroll") for (int k = 0; k < 2; ++k) dst[m][k] = *(const LAS bf16x8*)(lds + PG8_SA(b, h) + aoff + m * 2048 + k * 1024); } while (0)
#define PG8_LDB(dst, b, h) do { _Pragma("unroll") for (int n = 0; n < 2; ++n) _Pragma("unroll") for (int k = 0; k < 2; ++k) dst[n][k] = *(const LAS bf16x8*)(lds + PG8_SB(b, h) + boff + n * 2048 + k * 1024); } while (0)
#define PG8_MMA(ai, bj, At, Bt) do { __builtin_amdgcn_s_setprio(1); _Pragma("unroll") for (int m = 0; m < 4; ++m) _Pragma("unroll") for (int n = 0; n < 2; ++n) _Pragma("unroll") for (int k = 0; k < 2; ++k) \
        acc[ai][bj][m][n] = __builtin_amdgcn_mfma_f32_16x16x32_bf16(Bt[n][k], At[m][k], acc[ai][bj][m][n], 0, 0, 0); __builtin_amdgcn_s_setprio(0); } while (0)
#define PG8_WAIT_V(n) asm volatile("s_waitcnt vmcnt(" #n ")" ::: "memory")
#define PG8_WAIT_L(n) asm volatile("s_waitcnt lgkmcnt(" #n ")" ::: "memory")
#define PG8_BAR __builtin_amdgcn_s_barrier()
#define PG8_SCHED __builtin_amdgcn_sched_barrier(0)
    Unit cur, nxt; int ui = 0;
    if (!S.next(0, cur)) return;
    f32x4 acc[2][2][4][2];
#pragma unroll
    for (int a = 0; a < 2; ++a)
#pragma unroll
        for (int b = 0; b < 2; ++b)
#pragma unroll
            for (int m = 0; m < 4; ++m)
#pragma unroll
                for (int n = 0; n < 2; ++n) acc[a][b][m][n] = (f32x4){0.f, 0.f, 0.f, 0.f};
    bf16x8 At[4][2], B0[2][2], B1[2][2];
    const char* cA = (const char*)g.A + (size_t)cur.pm * tstepA + (size_t)cur.g * K * 2; const char* cB = (const char*)g.Bt + (size_t)cur.pn * tstepB + (size_t)cur.g * K * 2;
#if PG8_SP2
    PG8_STAGEB(PG8_SB(0, 0), cB, voffB); PG8_STAGEB(PG8_SB(0, 1), cB + hstepB, voffB); PG8_STAGE(PG8_SA(0, 0), cA, voffA); PG8_STAGE(PG8_SA(0, 1), cA + hstepA, voffA);
    if (wr == 1) PG8_BAR;
    PG8_WAIT_V(2); PG8_BAR;
    PG8_STAGEB(PG8_SB(1, 0), cB + kstep, voffB); PG8_STAGE(PG8_SA(1, 0), cA + kstep, voffA); PG8_STAGEB(PG8_SB(1, 1), cB + hstepB + kstep, voffB);
    PG8_WAIT_V(6); PG8_BAR;
#else
    PG8_STAGEB(PG8_SB(0, 0), cB, voffB); PG8_STAGE(PG8_SA(0, 0), cA, voffA); PG8_STAGEB(PG8_SB(0, 1), cB + hstepB, voffB); PG8_STAGE(PG8_SA(0, 1), cA + hstepA, voffA);
    if (wr == 1) PG8_BAR;
    PG8_WAIT_V(4); PG8_BAR;
    PG8_STAGEB(PG8_SB(1, 0), cB + kstep, voffB); PG8_STAGE(PG8_SA(1, 0), cA + kstep, voffA); PG8_STAGEB(PG8_SB(1, 1), cB + hstepB + kstep, voffB);
    PG8_WAIT_V(6); PG8_BAR;
#endif
    for (;;) {
        const bool has_next = S.next(ui + 1, nxt);
        const char* nA = has_next ? (const char*)g.A + (size_t)nxt.pm * tstepA + (size_t)nxt.g * K * 2 : cA; const char* nB = has_next ? (const char*)g.Bt + (size_t)nxt.pn * tstepB + (size_t)nxt.g * K * 2 : cB;
        for (int t = 0; t < nt; t += 2) {
            const bool last = (t == nt - 2);
            const char* a1 = cA + (size_t)(t + 1) * kstep;
            const char* a2 = last ? nA : cA + (size_t)(t + 2) * kstep; const char* b2 = last ? nB : cB + (size_t)(t + 2) * kstep;
            const char* a3 = a2 + kstep; const char* b3 = b2 + kstep;
#if PG8_SP2
            PG8_LDB(B0, 0, 0); PG8_LDB(B1, 0, 1); PG8_SCHED; PG8_LDA(At, 0, 0); PG8_STAGE(PG8_SA(1, 1), a1 + hstepA, voffA);
            PG8_WAIT_V(8); PG8_WAIT_L(0); PG8_BAR; PG8_MMA(0, 0, At, B0); PG8_MMA(0, 1, At, B1); PG8_BAR; PG8_SCHED;
            PG8_LDA(At, 0, 1); PG8_STAGEB(PG8_SB(0, 0), b2, voffB); PG8_STAGEB(PG8_SB(0, 1), b2 + hstepB, voffB); PG8_STAGE(PG8_SA(0, 0), a2, voffA);
            PG8_WAIT_V(8); PG8_WAIT_L(0); PG8_BAR; PG8_MMA(1, 0, At, B0); PG8_MMA(1, 1, At, B1); PG8_BAR; PG8_SCHED;
            PG8_LDB(B0, 1, 0); PG8_LDB(B1, 1, 1); PG8_SCHED; PG8_LDA(At, 1, 0); PG8_STAGE(PG8_SA(0, 1), a2 + hstepA, voffA);
            PG8_WAIT_V(8); PG8_WAIT_L(0); PG8_BAR; PG8_MMA(0, 0, At, B0); PG8_MMA(0, 1, At, B1); PG8_BAR; PG8_SCHED;
            PG8_LDA(At, 1, 1); PG8_STAGEB(PG8_SB(1, 0), b3, voffB); PG8_STAGEB(PG8_SB(1, 1), b3 + hstepB, voffB); PG8_STAGE(PG8_SA(1, 0), a3, voffA);
            PG8_WAIT_V(8); PG8_WAIT_L(0); PG8_BAR; PG8_MMA(1, 0, At, B0); PG8_MMA(1, 1, At, B1); PG8_BAR; PG8_SCHED;
        #else
            PG8_LDB(B0, 0, 0); PG8_SCHED; PG8_LDA(At, 0, 0); PG8_STAGE(PG8_SA(1, 1), a1 + hstepA, voffA);
            PG8_WAIT_L(8); PG8_BAR; PG8_WAIT_L(0); PG8_MMA(0, 0, At, B0); PG8_BAR; PG8_SCHED;
            PG8_LDB(B1, 0, 1); PG8_STAGEB(PG8_SB(0, 0), b2, voffB);
            PG8_BAR; PG8_WAIT_L(0); PG8_MMA(0, 1, At, B1); PG8_BAR;
            PG8_LDA(At, 0, 1); PG8_STAGE(PG8_SA(0, 0), a2, voffA);
            PG8_BAR; PG8_WAIT_L(0); PG8_MMA(1, 0, At, B0); PG8_BAR; PG8_SCHED;
            PG8_STAGEB(PG8_SB(0, 1), b2 + hstepB, voffB);
            PG8_WAIT_V(6); PG8_BAR; PG8_MMA(1, 1, At, B1); PG8_BAR;
            PG8_LDB(B0, 1, 0); PG8_SCHED; PG8_LDA(At, 1, 0); PG8_STAGE(PG8_SA(0, 1), a2 + hstepA, voffA);
            PG8_WAIT_L(8); PG8_BAR; PG8_WAIT_L(0); PG8_MMA(0, 0, At, B0); PG8_BAR; PG8_SCHED;
            PG8_LDB(B1, 1, 1); PG8_STAGEB(PG8_SB(1, 0), b3, voffB);
            PG8_BAR; PG8_WAIT_L(0); PG8_MMA(0, 1, At, B1); PG8_BAR;
            PG8_LDA(At, 1, 1); PG8_STAGE(PG8_SA(1, 0), a3, voffA);
            PG8_BAR; PG8_WAIT_L(0); PG8_MMA(1, 0, At, B0); PG8_BAR; PG8_SCHED;
            PG8_STAGEB(PG8_SB(1, 1), b3 + hstepB, voffB);
            PG8_WAIT_V(6); PG8_BAR; PG8_MMA(1, 1, At, B1); PG8_BAR;
#endif
        }
        if (wr == 0) PG8_BAR;
        if (g.tcnt != nullptr && wid == 0) {
            Unit u2;
            if (S.at(S.i0 + ui + 2, u2) && u2.pn >= T0_TILES) { unsigned* w = g.tcnt + 64 * u2.pn; unsigned sp = 0;
                while ((unsigned)__builtin_amdgcn_readfirstlane(xb_ld(w)) != 256u) { __builtin_amdgcn_s_sleep(2);
                    if ((++sp & 255u) == 0u) { if (xb_ld(&g.bar[XB_TMO])) break; if (sp > XB_SPIN_CAP) { atomicAdd(&g.bar[XB_TMO], 1u); break; } } }
                __builtin_amdgcn_fence(__ATOMIC_ACQUIRE, "agent"); } }
        E(acc, cur, wr, wc, fr, fq);
        if (!has_next) break;
        if (!Epi::CHAIN || nxt.g == 0) {
#pragma unroll
        for (int a = 0; a < 2; ++a)
#pragma unroll
            for (int b = 0; b < 2; ++b)
#pragma unroll
                for (int m = 0; m < 4; ++m)
#pragma unroll
                    for (int n = 0; n < 2; ++n) acc[a][b][m][n] = (f32x4){0.f, 0.f, 0.f, 0.f};
        }
        cur = nxt; cA = nA; cB = nB; ++ui;
        if (wr == 1) PG8_BAR;
    }
    PG8_WAIT_V(0);
    PG8_BAR;
#undef PG8_SA
#undef PG8_SB
#undef PG8_STAGE
#undef PG8_STAGEB
#undef PG8_STAGE_X
#undef PG8_LDA
#undef PG8_LDB
#undef PG8_MMA
#undef PG8_WAIT_V
#undef PG8_WAIT_L
#undef PG8_BAR
#undef PG8_SCHED
}
}

struct Frame {
    lds_u8* lds;
    int G, bid;
    unsigned char* ws;
};
__device__ __forceinline__ const float* in_ptr(int k) { asm volatile("" : "+s"(k)); return ((const float* const __attribute__((address_space(4)))*)__builtin_amdgcn_kernarg_segment_ptr())[k]; }
__device__ __forceinline__ float* out_ptr() { int k = 18; asm volatile("" : "+s"(k)); return ((float* const __attribute__((address_space(4)))*)__builtin_amdgcn_kernarg_segment_ptr())[k]; }
struct Args { const float* in[18]; float* out; unsigned char* ws; };

#define PHASE_TID() int tid = threadIdx.x; asm volatile("" : "+v"(tid)); const int lane = tid & 63; const int wave = __builtin_amdgcn_readfirstlane(tid >> 6); (void)lane; (void)wave
__device__ __forceinline__ bf16x8 frag_row(const lds_u8* tile, int pitch, int r0, int k0, int lane) {
    return *(const LAS bf16x8*)(tile + (r0 + (lane & 15)) * pitch + (k0 + (lane >> 4) * 8) * 2);
}
#ifndef TR_NAIVE
#define TR_NAIVE 0
#endif
__device__ __forceinline__ bf16x8 frag_tr(const lds_u8* tile, int pitch, int k0, int n0, int lane) {
#if TR_NAIVE
    bf16x8 f;
#pragma unroll
    for (int j = 0; j < 8; ++j) f[j] = *(const LAS short*)(tile + (k0 + 8 * (lane >> 4) + j) * pitch + (n0 + (lane & 15)) * 2);
    return f;
#else
    const int g = lane >> 4, i = lane & 15, q = i >> 2, p = i & 3;
    const lds_u8* a = tile + (k0 + 8 * g + q) * pitch + (n0 + 4 * p) * 2;
    const bf16x4 lo = __builtin_amdgcn_ds_read_tr16_b64_v4i16((LAS bf16x4*)a);
    const bf16x4 hi = __builtin_amdgcn_ds_read_tr16_b64_v4i16((LAS bf16x4*)(a + 4 * pitch));
    bf16x8 f; f[0] = lo[0]; f[1] = lo[1]; f[2] = lo[2]; f[3] = lo[3]; f[4] = hi[0]; f[5] = hi[1]; f[6] = hi[2]; f[7] = hi[3];
    return f;
#endif
}
template <bool A_TR, bool B_TR>
__device__ __forceinline__ void mm128(f32x4 (&acc)[2][4], const lds_u8* At, const lds_u8* Bt, int wave, int lane) {
    const int rb = (wave >> 1) * 32, cb = (wave & 1) * 64;
#pragma unroll
    for (int mi = 0; mi < 2; ++mi)
#pragma unroll
        for (int ni = 0; ni < 4; ++ni) acc[mi][ni] = (f32x4){0.f, 0.f, 0.f, 0.f};
#pragma unroll
    for (int kk = 0; kk < 4; ++kk) {
        bf16x8 a[2], b[4];
#pragma unroll
        for (int mi = 0; mi < 2; ++mi) a[mi] = A_TR ? frag_tr(At, TP, kk * 32, rb + mi * 16, lane) : frag_row(At, TP, rb + mi * 16, kk * 32, lane);
#pragma unroll
        for (int ni = 0; ni < 4; ++ni) b[ni] = B_TR ? frag_tr(Bt, TP, kk * 32, cb + ni * 16, lane) : frag_row(Bt, TP, cb + ni * 16, kk * 32, lane);
#pragma unroll
        for (int mi = 0; mi < 2; ++mi)
#pragma unroll
            for (int ni = 0; ni < 4; ++ni) acc[mi][ni] = __builtin_amdgcn_mfma_f32_16x16x32_bf16(a[mi], b[ni], acc[mi][ni], 0, 0, 0);
    }
}
__device__ __forceinline__ void acc_to_stage(const f32x4 (&acc)[2][4], LAS float* st, int wave, int lane) {
    const int rb = (wave >> 1) * 32 + 4 * (lane >> 4), cb = (wave & 1) * 64 + (lane & 15);
#pragma unroll
    for (int mi = 0; mi < 2; ++mi)
#pragma unroll
        for (int ni = 0; ni < 4; ++ni)
#pragma unroll
            for (int r = 0; r < 4; ++r) st[(rb + mi * 16 + r) * SP + cb + ni * 16] = acc[mi][ni][r];
}
__device__ __forceinline__ void tile_g2l(lds_u8* dst, const bf16_t* src, size_t gp, int tid) {
#pragma unroll
    for (int p = 0; p < 4; ++p) { const int row = p * 32 + (tid >> 4), cc = (tid & 15) * 8;
        *(LAS u32x4*)(dst + row * TP + cc * 2) = *(const u32x4*)(src + (size_t)row * gp + cc); }
}

__device__ __forceinline__ void tr_load(float (&v)[64], const float* src, size_t ldn, int lane) {
#pragma unroll
    for (int i = 0; i < 64; ++i) v[i] = src[(size_t)i * ldn + lane];
}
__device__ __forceinline__ void tr_finish(const float (&v)[64], bf16_t* dst, size_t dp, float scale, LAS float* scr, int lane) {
#pragma unroll
    for (int i = 0; i < 64; ++i) scr[i * 65 + lane] = v[i] * scale;
    LDS_WAIT(); asm volatile("" ::: "memory");
    const int c = lane & 7;
#pragma unroll
    for (int j = 0; j < 8; ++j) { const int n = (lane >> 3) + 8 * j; const LAS float* s = scr + (8 * c) * 65 + n;
        u32x4 o; o.x = pk2(s[0 * 65], s[1 * 65]); o.y = pk2(s[2 * 65], s[3 * 65]); o.z = pk2(s[4 * 65], s[5 * 65]); o.w = pk2(s[6 * 65], s[7 * 65]);
        *(u32x4*)(dst + (size_t)n * dp + 8 * c) = o; }
    LDS_WAIT(); asm volatile("" ::: "memory");
}
__device__ __forceinline__ void tr_item(const float* src, size_t ldn, bf16_t* dst, size_t dp, float scale, LAS float* scr, int lane) {
    float v[64]; tr_load(v, src, ldn, lane); tr_finish(v, dst, dp, scale, scr, lane);
}
__device__ __forceinline__ void tr_finish_wt(const float (&v)[64], __amdgpu_buffer_rsrc_t rsrc, unsigned off0, unsigned dpb, float scale, LAS float* scr, int lane) {
#pragma unroll
    for (int i = 0; i < 64; ++i) scr[i * 65 + lane] = v[i] * scale;
    LDS_WAIT(); asm volatile("" ::: "memory");
    const int c = lane & 7;
#pragma unroll
    for (int j = 0; j < 8; ++j) { const int n = (lane >> 3) + 8 * j; const LAS float* s = scr + (8 * c) * 65 + n;
        u32x4 o; o.x = pk2(s[0 * 65], s[1 * 65]); o.y = pk2(s[2 * 65], s[3 * 65]); o.z = pk2(s[4 * 65], s[5 * 65]); o.w = pk2(s[6 * 65], s[7 * 65]);
        __builtin_amdgcn_raw_buffer_store_b128(o, rsrc, off0 + (unsigned)n * dpb + 16u * c, 0, 16); }
    LDS_WAIT(); asm volatile("" ::: "memory");
}
template <class Setup>
__device__ __forceinline__ void tr_loop(int first, int step, int count, size_t ldn, size_t dp, LAS float* scr, int lane, const Setup& setup) {
    float va[64], vb[64];
    const float* sa; const float* sb; bf16_t* da; bf16_t* db; float ca = 1.f, cb = 1.f;
    int it = first;
    if (it < count) { setup(it, sa, da, ca); tr_load(va, sa, ldn, lane); }
    for (; it < count; it += 2 * step) {
        const int it2 = it + step, it3 = it2 + step;
        if (it2 < count) { setup(it2, sb, db, cb); tr_load(vb, sb, ldn, lane); }
        tr_finish(va, da, dp, ca, scr, lane);
        if (it3 < count) { setup(it3, sa, da, ca); tr_load(va, sa, ldn, lane); }
        if (it2 < count) tr_finish(vb, db, dp, cb, scr, lane);
    }
}
__device__ __forceinline__ void win_map(int n0, int lane, int& ns, float& sc) {
    int act = 0;
    if (n0 < C_OZ) ns = n0;
    else if (n0 >= C_G) { const int t = (n0 - C_G) >> 6, b = t & 3;
        const int g = 2 * (b >> 1) + ((lane >> 2) & 1), d = 64 * (t >> 2) + 16 * (2 * (b & 1) + (lane >> 5)) + 4 * ((lane >> 3) & 3) + (lane & 3);
        ns = 14352 + g * DM + d - lane; act = 1; }
    else if (n0 >= C_VG && n0 < C_BZ) { ns = n0 < C_XC ? 6160 + (n0 - C_VG) : (n0 < C_ZC ? 8208 + (n0 - C_XC) : 9232 + (n0 - C_ZC)); act = n0 >= C_ZC; }
    else { const int base = n0 < C_UZ ? C_OZ : (n0 < C_VG ? C_UZ : (n0 < C_CX ? C_BZ : C_CX)); const int sa = base == C_OZ ? 3072 : (base == C_UZ ? 5136 : (base == C_BZ ? 10256 : 11280)), sb = base == C_OZ ? 4096 : (base == C_UZ ? 7184 : (base == C_BZ ? 13328 : 12304));
        const int w = (n0 - base) & 255, hf = w >> 7; ns = (hf ? sb : sa) + ((n0 - base) >> 8) * 128 + (w & 127);
        act = base == C_OZ ? 1 : ((base == C_UZ || base == C_BZ) ? hf : 0); }
    sc = (n0 >= C_K && n0 < C_V) ? 0.08838834764831845f : (act ? -1.4426950408889634f : 1.0f);
}
__device__ __forceinline__ void p0_win0_tiles(Frame& F, int t0, int t1, int wg_rank, int nw, bool counted) {
    PHASE_TID();
    const int rank = wg_rank * 8 + wave;
    LAS float* scr = (LAS float*)(F.lds + wave * 16640);
    const float* w_in = in_ptr(3); bf16_t* WIN = (bf16_t*)(F.ws + WS_WIN);
    if (!counted) {
        for (int r = t0 * 256 + rank; r < t1 * 256; r += nw) {
            const int kb = (r & 255) >> 2, n0 = ((r >> 8) * 4 + (r & 3)) * 64; int ns; float sc; win_map(n0, lane, ns, sc);
            tr_item(w_in + (size_t)(kb * 64) * PROJ_W + ns, PROJ_W, WIN + (size_t)n0 * DM + kb * 64, DM, sc, scr, lane); }
    } else {
        const __amdgpu_buffer_rsrc_t rsrc = __builtin_amdgcn_make_buffer_rsrc(WIN, 0, NP * DM * 2, 0x00020000);
        unsigned* tcnt = (unsigned*)(F.ws + WS_CTL) + CW_TCNT;
        for (int r = t0 * 256 + rank; r < t1 * 256; r += nw) {
            const int kb = (r & 255) >> 2, n0 = ((r >> 8) * 4 + (r & 3)) * 64; int ns; float sc; win_map(n0, lane, ns, sc);
            float v[64]; tr_load(v, w_in + (size_t)(kb * 64) * PROJ_W + ns, PROJ_W, lane);
            tr_finish_wt(v, rsrc, (unsigned)(((size_t)n0 * DM + kb * 64) * 2), (unsigned)(DM * 2), sc, scr, lane);
            asm volatile("s_waitcnt vmcnt(0)" ::: "memory");
            if (lane == 0) __hip_atomic_fetch_add(tcnt + 64 * (r >> 8), 1u, __ATOMIC_RELAXED, __HIP_MEMORY_SCOPE_AGENT);
        }
    }
}
__device__ __forceinline__ void p0_prologue(Frame& F, int l0, int l1, int parts) {
    PHASE_TID();
    LAS float* scr = (LAS float*)(F.lds + wave * 16640);
    const int gw = F.bid * 8 + wave, NGW = F.G * 8;
    const float* w_in = in_ptr(3); const float* w_branch = in_ptr(16); const float* w_out = in_ptr(17); const float* rgw = in_ptr(12);
    bf16_t* WIN = (bf16_t*)(F.ws + WS_WIN); bf16_t* WBR = (bf16_t*)(F.ws + WS_WBR); bf16_t* WOUT = (bf16_t*)(F.ws + WS_WOUT); bf16_t* RWT = (bf16_t*)(F.ws + WS_RWT);
    if (parts & 1) {
    constexpr int I_IN = 64 * 480;
    tr_loop(l0 * I_IN + gw, NGW, l1 * I_IN, PROJ_W, DM, scr, lane, [&](int it, const float*& src_, bf16_t*& dst_, float& sc_) {
        const int l = it / I_IN, r = it % I_IN, kb = r / 480, nb = r % 480, n0 = nb * 64;
        int ns; float sc; win_map(n0, lane, ns, sc);
        src_ = w_in + ((size_t)l * DM + kb * 64) * PROJ_W + ns; dst_ = WIN + ((size_t)l * NP + n0) * DM + kb * 64; sc_ = sc;
    });
    }
    if (parts & 2) {
    constexpr int I_BR = 16 * 64;
    tr_loop(l0 * 4 * I_BR + gw, NGW, l1 * 4 * I_BR, DM, DM, scr, lane, [&](int it, const float*& src_, bf16_t*& dst_, float& sc_) {
        const int lg = it / I_BR, r = it % I_BR, l = lg >> 2, g = lg & 3, kb = r / 64, nb = r % 64;
        src_ = w_branch + ((size_t)lg * BW + kb * 64) * DM + nb * 64; dst_ = WBR + ((size_t)l * DM + nb * 64) * DM + g * BW + kb * 64; sc_ = 1.0f;
    });
    constexpr int I_O = 64 * 64;
    tr_loop(l0 * I_O + gw, NGW, l1 * I_O, DM, DM, scr, lane, [&](int it, const float*& src_, bf16_t*& dst_, float& sc_) {
        const int l = it / I_O, r = it % I_O, kb = r / 64, nb = r % 64;
        src_ = w_out + ((size_t)l * DM + kb * 64) * DM + nb * 64; dst_ = WOUT + ((size_t)l * DM + nb * 64) * DM + kb * 64; sc_ = 1.0f;
    });
    }
    if (!(parts & 4)) return;
    for (int it = l0 * 64 + gw; it < l1 * 64; it += NGW) {
        const int ln = it >> 3, r = it & 7, kb = r >> 2, nb = r & 3;
        tr_item(rgw + ((size_t)ln * 128 + kb * 64) * 256 + nb * 64, 256, RWT + ((size_t)ln * 256 + nb * 64) * 128 + kb * 64, 128, 1.0f, scr, lane);
    }
    if (l0 != 0) return;
    const int gt = F.bid * 512 + tid, NGT = F.G * 512;
    bf16_t* GWT = (bf16_t*)(F.ws + WS_GWT); const float* gws = in_ptr(8);
    { float* SPL = (float*)(F.ws + WS_SPL); const float* ap = in_ptr(14);
      for (int i = gt; i < DEPTH * BW; i += NGT) { const float av = ap[i]; SPL[i] = -8.0f * ((av > 0.f) ? log1pf(expf(-av)) : (-av + log1pf(expf(av)))); } }
    for (int i = gt; i < DEPTH * 8 * 128 * 128; i += NGT) { const int s = i & 127, t = (i >> 7) & 127;
        GWT[i] = (bf16_t)f2bf(s <= t ? gws[i] : 0.f); }
}

__device__ __forceinline__ void norm_phase(Frame& F, int l) {
    PHASE_TID();
    const bool has_next = l < DEPTH;
    const float* x0 = in_ptr(0);
    bf16_t* H = (bf16_t*)(F.ws + WS_H); float* GATES = (float*)(F.ws + WS_GATES);
    constexpr int WGP = 8208;
    LAS float* sPart = (LAS float*)(F.lds + 16 * WGP);
    __syncthreads();
    if (has_next) {
        const float* wg = in_ptr(3) + (size_t)l * DM * PROJ_W + 5120;
        for (int k = tid; k < DM; k += 512) { const f32x4* p = (const f32x4*)(wg + (size_t)k * PROJ_W);
#pragma unroll
            for (int q = 0; q < 4; ++q) { const f32x4 w = p[q];
#pragma unroll
                for (int j = 0; j < 4; ++j) *(LAS unsigned short*)(F.lds + (q * 4 + j) * WGP + k * 2) = (unsigned short)f2bf(w[j]); } }
    }
    for (int blk = F.bid; blk < SEQ / 32; blk += F.G) {
        for (int ri = 0; ri < 4; ++ri) {
            const int row = blk * 32 + wave * 4 + ri;
            f32x4 v[16];
            if (l < 2) {
                const f32x4* xp = (const f32x4*)(x0 + (size_t)row * DM) + lane;
#pragma unroll
                for (int j = 0; j < 16; ++j) v[j] = xp[64 * j];
            } else {
                const u32x2* rp = (const u32x2*)(F.ws + WS_XR + (size_t)row * DM * 2) + lane;
#pragma unroll
                for (int j = 0; j < 16; ++j) { const u32x2 o = rp[64 * j];
                    v[j][0] = __uint_as_float(o.x << 16); v[j][1] = __uint_as_float(o.x & 0xffff0000u); v[j][2] = __uint_as_float(o.y << 16); v[j][3] = __uint_as_float(o.y & 0xffff0000u); }
            }
            for (int pl = (l < 2 ? 0 : l - 1); pl < l; ++pl) {
                const float* SS = (const float*)(F.ws + (pl == 0 ? WS_SS : WS_SS1));
                const float rstd_o = 1.0f / sqrtf(wave_sum(SS[(size_t)row * 64 + lane]) * (1.0f / DM) + EPS);
                const u32x2* op = (const u32x2*)(F.ws + WS_OUT + (size_t)pl * OUT_L + (size_t)row * DM * 2) + lane; const f32x4* pw = (const f32x4*)(in_ptr(2) + (size_t)pl * DM) + lane;
#pragma unroll
                for (int j = 0; j < 16; ++j) { const u32x2 o = op[64 * j]; const f32x4 w = pw[64 * j];
                    v[j][0] += __uint_as_float(o.x << 16) * rstd_o * w[0]; v[j][1] += __uint_as_float(o.x & 0xffff0000u) * rstd_o * w[1];
                    v[j][2] += __uint_as_float(o.y << 16) * rstd_o * w[2]; v[j][3] += __uint_as_float(o.y & 0xffff0000u) * rstd_o * w[3]; }
            }
            if (!has_next) {
                f32x4* xo = (f32x4*)(out_ptr() + (size_t)row * DM) + lane;
#pragma unroll
                for (int j = 0; j < 16; ++j) xo[64 * j] = v[j];
            } else {
                float s2 = 0.f;
#pragma unroll
                for (int j = 0; j < 16; ++j) s2 += (v[j][0] * v[j][0] + v[j][1] * v[j][1]) + (v[j][2] * v[j][2] + v[j][3] * v[j][3]);
                const float rstd = 1.0f / sqrtf(wave_sum(s2) * (1.0f / DM) + EPS);
                const f32x4* pw = (const f32x4*)(in_ptr(1) + (size_t)l * DM) + lane;
                u32x2* ho = (u32x2*)(H + (size_t)row * DM) + lane;
                if (l >= 1) { u32x2* ro = (u32x2*)(F.ws + WS_XR + (size_t)row * DM * 2) + lane;
#pragma unroll
                    for (int j = 0; j < 16; ++j) { u32x2 w; w.x = pk2(v[j][0], v[j][1]); w.y = pk2(v[j][2], v[j][3]); ro[64 * j] = w; } }
#pragma unroll
                for (int j = 0; j < 16; ++j) { const f32x4 hv = v[j] * rstd * pw[64 * j]; u32x2 w; w.x = pk2(hv[0], hv[1]); w.y = pk2(hv[2], hv[3]); ho[64 * j] = w; }
            }
        }
        if (has_next) {
            asm volatile("s_waitcnt vmcnt(0)" ::: "memory");
            __syncthreads();
            const int mt = wave >> 2, kq = wave & 3;
            const bf16_t* hA = H + (size_t)(blk * 32 + mt * 16 + (lane & 15)) * DM + kq * 1024 + 8 * (lane >> 4);
            const lds_u8* wB = F.lds + (lane & 15) * WGP + (kq * 1024 + 8 * (lane >> 4)) * 2;
            f32x4 acc = (f32x4){0.f, 0.f, 0.f, 0.f};
#pragma unroll
            for (int hb = 0; hb < 2; ++hb) { bf16x8 a[16];
#pragma unroll
                for (int kk = 0; kk < 16; ++kk) a[kk] = *(const bf16x8*)(hA + (hb * 16 + kk) * 32);
#pragma unroll
                for (int kk = 0; kk < 16; ++kk) { const bf16x8 bw = *(const LAS bf16x8*)(wB + (hb * 16 + kk) * 64); acc = __builtin_amdgcn_mfma_f32_16x16x32_bf16(a[kk], bw, acc, 0, 0, 0); } }
            *(LAS f32x4*)(sPart + (wave * 64 + lane) * 4) = acc;
            __syncthreads();
            { const int row = tid >> 4, n = tid & 15, m2 = row >> 4, r = row & 15, ln = (r >> 2) * 16 + n, rg = r & 3; float sum = 0.f;
#pragma unroll
              for (int q = 0; q < 4; ++q) sum += sPart[((m2 * 4 + q) * 64 + ln) * 4 + rg];
              GATES[(size_t)(blk * 32 + row) * 16 + n] = sum + in_ptr(4)[(size_t)l * 16 + n]; }
        }
    }
    __syncthreads();
}

__device__ __forceinline__ float log_sigmoidf_(float x) { return x >= 0.f ? -log1pf(expf(-x)) : x - log1pf(expf(x)); }

struct SconvRegs { u32x4 cxv[4][3], bzv[4]; };
__device__ __forceinline__ void sconv_load(Frame& F, int unit, int tid, SconvRegs& R) {
    const int c = unit >> 3, n = unit & 7, t0 = c * LCH;
    const bf16_t* PROJ = (const bf16_t*)(F.ws + WS_PROJ);
    const int chg = n * 128 + (tid & 15) * 8;
#pragma unroll
    for (int p = 0; p < 4; ++p) { const int t = t0 + p * 32 + (tid >> 4);
#pragma unroll
        for (int k = 0; k < 3; ++k) { const int ts = t - 2 + k, tc = ts < 0 ? 0 : ts; R.cxv[p][k] = *(const u32x4*)(PROJ + (size_t)tc * NP + C_CX + chg); }
        R.bzv[p] = *(const u32x4*)(PROJ + (size_t)t * NP + C_BZ + chg); }
}
__device__ __forceinline__ void sconv_finish(Frame& F, int unit, int l, int tid, const SconvRegs& R) {
    const int c = unit >> 3, n = unit & 7, t0 = c * LCH;
    const float* sw = in_ptr(15) + (size_t)l * 3 * BW; bf16_t* YS = (bf16_t*)(F.ws + WS_YS);
    const int chg = n * 128 + (tid & 15) * 8;
    float w[3][8];
#pragma unroll
    for (int k = 0; k < 3; ++k) { const f32x4 a = *(const f32x4*)(sw + k * BW + chg), b = *(const f32x4*)(sw + k * BW + chg + 4);
#pragma unroll
        for (int j = 0; j < 4; ++j) { w[k][j] = a[j]; w[k][4 + j] = b[j]; } }
#pragma unroll
    for (int p = 0; p < 4; ++p) { const int t = t0 + p * 32 + (tid >> 4);
        float acc[8];
#pragma unroll
        for (int j = 0; j < 8; ++j) acc[j] = 0.f;
#pragma unroll
        for (int k = 0; k < 3; ++k) { const float msk = (t - 2 + k >= 0) ? 1.0f : 0.0f; float cx[8]; unpack8(R.cxv[p][k], cx);
#pragma unroll
            for (int j = 0; j < 8; ++j) acc[j] += (msk * w[k][j]) * cx[j]; }
        float bz[8]; unpack8(R.bzv[p], bz);
        float y[8];
#pragma unroll
        for (int j = 0; j < 8; ++j) y[j] = bz[j] * acc[j];
        *(u32x4*)(YS + (size_t)t * DM + 3 * BW + chg) = pack8(y); }
}

__device__ __forceinline__ void mlstm_c1(Frame& F, int unit, int l) {
    PHASE_TID();
    SconvRegs SR; sconv_load(F, unit, tid, SR);
    const int h = unit >> 6, c = unit & 63, t0 = c * LCH;
    const bf16_t* PROJ = (const bf16_t*)(F.ws + WS_PROJ); const float* GATES = (const float*)(F.ws + WS_GATES);
    lds_u8* Vs = F.lds; lds_u8* Ks = F.lds + TILE_B;
    LAS float* sA = (LAS float*)(F.lds + SCAL_OFF); LAS float* sX = sA + 128; LAS float* sP = sA + 256;
    u32x4 vreg[4], kreg[4];
#pragma unroll
    for (int p = 0; p < 4; ++p) { const int row = p * 32 + (tid >> 4), cc = (tid & 15) * 8; const size_t gro = (size_t)(t0 + row) * NP + h * 128 + cc;
        vreg[p] = *(const u32x4*)(PROJ + gro + C_V); kreg[p] = *(const u32x4*)(PROJ + gro + C_K); }
    __syncthreads();
    if (wave == 0) {
        const int t = 2 * lane;
        const float lf0 = log_sigmoidf_(GATES[(size_t)(t0 + t) * 16 + 8 + h]), lf1 = log_sigmoidf_(GATES[(size_t)(t0 + t + 1) * 16 + 8 + h]);
        const float i0 = GATES[(size_t)(t0 + t) * 16 + h], i1 = GATES[(size_t)(t0 + t + 1) * 16 + h];
        float sc = lf0 + lf1;
#pragma unroll
        for (int d = 1; d < 64; d <<= 1) { const float o = __shfl_up(sc, d); if (lane >= d) sc += o; }
        const float b1 = sc, b0 = sc - lf1, a0 = i0 - b0, a1 = i1 - b1;
        float mx = fmaxf(a0, a1);
#pragma unroll
        for (int d = 1; d < 64; d <<= 1) { const float o = __shfl_up(mx, d); if (lane >= d) mx = fmaxf(mx, o); }
        float mprev = __shfl_up(mx, 1); if (lane == 0) mprev = -3.0e38f;
        const float u0 = fmaxf(mprev, a0), u1 = mx;
        float* TB = (float*)(F.ws + WS_TB) + (size_t)h * SEQ + t0; float* TA = TB + (size_t)8 * SEQ; float* TU = TA + (size_t)8 * SEQ;
        *(f32x2*)(TB + t) = (f32x2){b0, b1}; *(f32x2*)(TA + t) = (f32x2){a0, a1}; *(f32x2*)(TU + t) = (f32x2){u0, u1};
        sA[t] = a0; sA[t + 1] = a1;
        if (lane == 63) { sX[0] = u1; float* BL = (float*)(F.ws + WS_DN + 256 * 1024); float* ML = BL + 1024; BL[h * 64 + c] = b1; ML[h * 64 + c] = b1 + u1; }
    }
    __syncthreads();
    const float umax = sX[0];
#pragma unroll
    for (int p = 0; p < 4; ++p) { const int row = p * 32 + (tid >> 4), cc = (tid & 15) * 8;
        *(LAS u32x4*)(Vs + row * TP + cc * 2) = vreg[p];
        float kf[8]; unpack8(kreg[p], kf); const float w = __expf(sA[row] - umax);
#pragma unroll
        for (int j = 0; j < 8; ++j) kf[j] *= w;
        *(LAS u32x4*)(Ks + row * TP + cc * 2) = pack8(kf); }
    __syncthreads();
    f32x4 acc[2][4];
    mm128<true, true>(acc, Ks, Vs, wave, lane);
    sconv_finish(F, unit, l, tid, SR);
    float* DC = (float*)(F.ws + WS_DC) + (size_t)unit * 16384;
    { const int db = (wave >> 1) * 32 + 4 * (lane >> 4), eb = (wave & 1) * 64 + (lane & 15);
#pragma unroll
      for (int mi = 0; mi < 2; ++mi)
#pragma unroll
        for (int ni = 0; ni < 4; ++ni) *(f32x4*)(DC + (eb + ni * 16) * 128 + db + mi * 16) = acc[mi][ni]; }
    { const int d = tid & 127, sg = tid >> 7; float sum = 0.f;
#pragma unroll 8
      for (int t = 0; t < 32; ++t) sum += bf2f(*(const LAS unsigned short*)(Ks + (sg * 32 + t) * TP + d * 2));
      sP[sg * 128 + d] = sum; }
    __syncthreads();
    if (tid < 128) ((float*)(F.ws + WS_DN))[(size_t)unit * 128 + tid] = (sP[tid] + sP[128 + tid]) + (sP[256 + tid] + sP[384 + tid]);
}

__device__ __forceinline__ void mlstm_c2(Frame& F) {
    PHASE_TID();
    const float* DC = (const float*)(F.ws + WS_DC); const float* DN = (const float*)(F.ws + WS_DN);
    const float* BL = (const float*)(F.ws + WS_DN + 256 * 1024); const float* ML = BL + 1024;
    bf16_t* CST = (bf16_t*)(F.ws + WS_CST); float* NST = (float*)(F.ws + WS_NST); float* MST = (float*)(F.ws + WS_NST + 256 * 1024);
    for (int e = F.bid * 512 + tid; e < 8 * 16384; e += F.G * 512) {
        const int h = e >> 14, idx = e & 16383; const bool hasn = idx < 128;
        float m = 0.f, C = 0.f, n = 0.f;
        for (int c0 = 0; c0 < NCH; c0 += 32) {
            float dc[32], dn[32];
#pragma unroll
            for (int q = 0; q < 32; ++q) { const size_t u = (size_t)h * 64 + c0 + q; dc[q] = DC[u * 16384 + idx]; dn[q] = hasn ? DN[u * 128 + idx] : 0.f; }
#pragma unroll
            for (int q = 0; q < 32; ++q) { const size_t u = (size_t)h * 64 + c0 + q;
                CST[u * 16384 + idx] = (bf16_t)f2bf(C);
                if (hasn) NST[u * 128 + idx] = n;
                if (idx == 0) MST[u] = m;
                const float bl = BL[u], ml = ML[u];
                const float mn = fmaxf(bl + m, ml), dec = __expf(bl + m - mn), sc = __expf(ml - mn);
                C = dec * C + sc * dc[q]; n = dec * n + sc * dn[q]; m = mn; }
        }
    }
}

__device__ __forceinline__ void mlstm_c3(Frame& F, int unit, int l) {
    PHASE_TID();
    const int h = unit >> 6, c = unit & 63, t0 = c * LCH;
    const bf16_t* PROJ = (const bf16_t*)(F.ws + WS_PROJ);
    lds_u8* Ks = F.lds; lds_u8* Vs = F.lds + TILE_B; lds_u8* Cs = F.lds + 2 * TILE_B; lds_u8* Ps = F.lds + 3 * TILE_B;
    LAS float* sA = (LAS float*)(F.lds + SCAL_OFF); LAS float* sM = sA + 128; LAS float* sWi = sA + 256; LAS float* sEm = sA + 384; LAS float* sN = sA + 512;
    const int rw = wave * 16, fr = lane & 15, fq = lane >> 4;
    bf16x8 qf[4];
    { const bf16_t* qrow = PROJ + (size_t)(t0 + rw + fr) * NP + C_Q + h * 128 + 8 * fq;
#pragma unroll
      for (int kk = 0; kk < 4; ++kk) qf[kk] = *(const bf16x8*)(qrow + kk * 32); }
    u32x4 ozreg[4]; f32x4 nwv[4][2];
    { const float* nw = in_ptr(5) + (size_t)l * BW + h * 128;
#pragma unroll
      for (int it = 0; it < 4; ++it) { const int idx = lane + 64 * (it & 1), row = idx >> 3, e = 64 * (it >> 1) + 8 * (idx & 7); const size_t gro = (size_t)(t0 + rw + row) * NP + h * 128 + e;
        ozreg[it] = *(const u32x4*)(PROJ + gro + C_OZ); nwv[it][0] = *(const f32x4*)(nw + e); nwv[it][1] = *(const f32x4*)(nw + e + 4); } }
    __syncthreads();
    tile_g2l(Ks, PROJ + (size_t)t0 * NP + C_K + h * 128, NP, tid);
    tile_g2l(Vs, PROJ + (size_t)t0 * NP + C_V + h * 128, NP, tid);
    tile_g2l(Cs, (const bf16_t*)(F.ws + WS_CST) + (size_t)unit * 16384, 128, tid);
    if (tid < 128) {
        const float* TB = (const float*)(F.ws + WS_TB) + (size_t)h * SEQ + t0; const float* TA = TB + (size_t)8 * SEQ; const float* TU = TA + (size_t)8 * SEQ;
        const float mc = ((const float*)(F.ws + WS_NST + 256 * 1024))[unit];
        const float b = TB[tid], a = TA[tid], u = TU[tid], M = fmaxf(mc, u);
        sA[tid] = a; sM[tid] = M; sWi[tid] = __expf(mc - M); sEm[tid] = __expf(-(b + M));
        sN[tid] = ((const float*)(F.ws + WS_NST))[(size_t)unit * 128 + tid];
    }
    __syncthreads();
    f32x4 accS[8];
#pragma unroll
    for (int ni = 0; ni < 8; ++ni) { accS[ni] = (f32x4){0.f, 0.f, 0.f, 0.f};
        if (ni <= wave) {
#pragma unroll
            for (int kk = 0; kk < 4; ++kk) accS[ni] = __builtin_amdgcn_mfma_f32_16x16x32_bf16(qf[kk], frag_row(Ks, TP, 16 * ni, kk * 32, lane), accS[ni], 0, 0, 0); } }
    float denr[4], Mr[4];
#pragma unroll
    for (int r = 0; r < 4; ++r) { const int t = rw + 4 * fq + r; Mr[r] = sM[t]; float ds = 0.f;
#pragma unroll
        for (int ni = 0; ni < 8; ++ni) { const int sx = 16 * ni + fr; float pv = 0.f;
            if (ni <= wave) { const float e = __expf(sA[sx] - Mr[r]); pv = (sx <= t) ? accS[ni][r] * e : 0.f; }
            ds += pv; *(LAS unsigned short*)(Ps + t * TP + sx * 2) = (unsigned short)f2bf(pv); }
        ds += __shfl_xor(ds, 1); ds += __shfl_xor(ds, 2); ds += __shfl_xor(ds, 4); ds += __shfl_xor(ds, 8); denr[r] = ds; }
    f32x4 accB[8];
#pragma unroll
    for (int ni = 0; ni < 8; ++ni) { accB[ni] = (f32x4){0.f, 0.f, 0.f, 0.f};
#pragma unroll
        for (int kk = 0; kk < 4; ++kk) accB[ni] = __builtin_amdgcn_mfma_f32_16x16x32_bf16(qf[kk], frag_row(Cs, TP, 16 * ni, kk * 32, lane), accB[ni], 0, 0, 0); }
    float nqv = 0.f;
#pragma unroll
    for (int kk = 0; kk < 4; ++kk) { const f32x4 n0 = *(const LAS f32x4*)(sN + kk * 32 + 8 * fq), n1 = *(const LAS f32x4*)(sN + kk * 32 + 8 * fq + 4);
#pragma unroll
        for (int j = 0; j < 4; ++j) { nqv += bf2f((unsigned short)qf[kk][j]) * n0[j]; nqv += bf2f((unsigned short)qf[kk][4 + j]) * n1[j]; } }
    nqv += __shfl_xor(nqv, 16); nqv += __shfl_xor(nqv, 32);
    asm volatile("s_waitcnt lgkmcnt(0)" ::: "memory");
    f32x4 accA[8];
#pragma unroll
    for (int ni = 0; ni < 8; ++ni) accA[ni] = (f32x4){0.f, 0.f, 0.f, 0.f};
    const int kmax = (rw + 15) >> 5;
#pragma unroll
    for (int kk = 0; kk < 4; ++kk) { if (kk <= kmax) { const bf16x8 pa = frag_row(Ps, TP, rw, kk * 32, lane);
#pragma unroll
        for (int ni = 0; ni < 8; ++ni) accA[ni] = __builtin_amdgcn_mfma_f32_16x16x32_bf16(pa, frag_tr(Vs, TP, kk * 32, 16 * ni, lane), accA[ni], 0, 0, 0); } }
#pragma unroll
    for (int r = 0; r < 4; ++r) { const int t = rw + 4 * fq + r; const float wi = sWi[t]; const float nqr = __shfl(nqv, 4 * fq + r);
        const float den = denr[r] + wi * nqr; const float inv = 1.0f / fmaxf(fabsf(den), sEm[t]); float ss = 0.f;
#pragma unroll
        for (int ni = 0; ni < 8; ++ni) { const float hv = (accA[ni][r] + wi * accB[ni][r]) * inv; accA[ni][r] = hv; ss += hv * hv; }
        ss += __shfl_xor(ss, 1); ss += __shfl_xor(ss, 2); ss += __shfl_xor(ss, 4); ss += __shfl_xor(ss, 8);
        const float rinv = 1.0f / sqrtf(ss * (1.0f / 128.0f) + EPS);
#pragma unroll
        for (int ni = 0; ni < 8; ++ni) accA[ni][r] *= rinv; }
    bf16_t* YS = (bf16_t*)(F.ws + WS_YS);
    LAS float* stw = (LAS float*)(Ps + rw * TP);
#pragma unroll
    for (int hf = 0; hf < 2; ++hf) {
        asm volatile("s_waitcnt lgkmcnt(0)" ::: "memory");
#pragma unroll
        for (int q = 0; q < 4; ++q)
#pragma unroll
            for (int r = 0; r < 4; ++r) stw[(4 * fq + r) * 68 + 16 * q + fr] = accA[4 * hf + q][r];
        asm volatile("s_waitcnt lgkmcnt(0)" ::: "memory");
#pragma unroll
        for (int i = 0; i < 2; ++i) { const int it = 2 * hf + i, idx = lane + 64 * i, row = idx >> 3, e = 64 * hf + 8 * (idx & 7);
            const f32x4 x0 = *(const LAS f32x4*)(stw + row * 68 + 8 * (idx & 7)), x1 = *(const LAS f32x4*)(stw + row * 68 + 8 * (idx & 7) + 4);
            float oz[8]; unpack8(ozreg[it], oz);
            float y[8];
#pragma unroll
            for (int j = 0; j < 4; ++j) { y[j] = x0[j] * nwv[it][0][j] * oz[j]; y[4 + j] = x1[j] * nwv[it][1][j] * oz[4 + j]; }
            *(u32x4*)(YS + (size_t)(t0 + rw + row) * DM + h * 128 + e) = pack8(y); }
    }
}

__device__ __forceinline__ void gmlp_stats(Frame& F) {
    PHASE_TID();
    const bf16_t* PROJ = (const bf16_t*)(F.ws + WS_PROJ); f32x2* LNS = (f32x2*)(F.ws + WS_LNS);
    for (int r0 = (F.bid * 8 + wave) * 4; r0 < SEQ; r0 += F.G * 8 * 4) {
        u32x4 v[4][2];
#pragma unroll
        for (int i = 0; i < 4; ++i) { const bf16_t* p = PROJ + (size_t)(r0 + i) * NP + C_VG + lane * 16; v[i][0] = *(const u32x4*)p; v[i][1] = *(const u32x4*)(p + 8); }
#pragma unroll
        for (int i = 0; i < 4; ++i) { float f[8], g8[8]; unpack8(v[i][0], f); unpack8(v[i][1], g8); float sm = 0.f, s2 = 0.f;
#pragma unroll
            for (int j = 0; j < 8; ++j) { sm += f[j] + g8[j]; s2 += f[j] * f[j] + g8[j] * g8[j]; }
            sm = wave_sum(sm); s2 = wave_sum(s2);
            const float mean = sm * (1.0f / 1024.0f), var = fmaxf(s2 * (1.0f / 1024.0f) - mean * mean, 0.f);
            if (lane == 0) LNS[r0 + i] = (f32x2){mean, 1.0f / sqrtf(var + EPS)}; }
    }
}

__device__ __forceinline__ void gmlp_unit(Frame& F, int unit, int l) {
    PHASE_TID();
    const int c = (unit & 7) + 8 * (unit >> 6), g = (unit >> 3) & 7, t0 = c * LCH;
    const bf16_t* PROJ = (const bf16_t*)(F.ws + WS_PROJ);
    lds_u8* Ws = F.lds; lds_u8* Vn = F.lds + TILE_B; LAS float* st = (LAS float*)(F.lds + 2 * TILE_B);
    u32x4 uzreg[4], vgreg[4], wreg[4];
    { const bf16_t* GW = (const bf16_t*)(F.ws + WS_GWT) + ((size_t)l * 8 + g) * 16384;
#pragma unroll
      for (int p = 0; p < 4; ++p) { const int row = p * 32 + (tid >> 4), cc = (tid & 15) * 8; const size_t gro = (size_t)(t0 + row) * NP + g * 128 + cc;
        uzreg[p] = *(const u32x4*)(PROJ + gro + C_UZ); vgreg[p] = *(const u32x4*)(PROJ + gro + C_VG); wreg[p] = *(const u32x4*)(GW + (size_t)row * 128 + cc); } }
    f32x2 mr[4];
#pragma unroll
    for (int p = 0; p < 4; ++p) mr[p] = ((const f32x2*)(F.ws + WS_LNS))[t0 + p * 32 + (tid >> 4)];
    __syncthreads();
    const float* lnw = in_ptr(6) + (size_t)l * BW + g * 128; const float* lnb = in_ptr(7) + (size_t)l * BW + g * 128;
#pragma unroll
    for (int p = 0; p < 4; ++p) { const int row = p * 32 + (tid >> 4), cc = (tid & 15) * 8;
        *(LAS u32x4*)(Ws + row * TP + cc * 2) = wreg[p];
        float f[8]; unpack8(vgreg[p], f); const float mean = mr[p][0], rstd = mr[p][1];
#pragma unroll
        for (int j = 0; j < 8; ++j) f[j] = (f[j] - mean) * rstd * lnw[cc + j] + lnb[cc + j];
        *(LAS u32x4*)(Vn + row * TP + cc * 2) = pack8(f); }
    __syncthreads();
    f32x4 acc[2][4];
    mm128<false, true>(acc, Ws, Vn, wave, lane);
    acc_to_stage(acc, st, wave, lane);
    __syncthreads();
    const float* bs = in_ptr(9) + ((size_t)l * 8 + g) * 128; bf16_t* YS = (bf16_t*)(F.ws + WS_YS);
#pragma unroll
    for (int p = 0; p < 4; ++p) { const int t = p * 32 + (tid >> 4), cc = (tid & 15) * 8;
        float uz[8]; unpack8(uzreg[p], uz); const float b = bs[t];
        float y[8];
#pragma unroll
        for (int j = 0; j < 8; ++j) y[j] = uz[j] * (st[t * SP + cc + j] + b);
        *(u32x4*)(YS + (size_t)(t0 + t) * DM + BW + g * 128 + cc) = pack8(y); }
}

__device__ __forceinline__ void rglru_c1(Frame& F, int unit, int l) {
    PHASE_TID();
    const int c = unit >> 3, n = unit & 7, t0 = c * LCH;
    const bf16_t* PROJ = (const bf16_t*)(F.ws + WS_PROJ);
    lds_u8* Xs = F.lds; LAS float* XF = (LAS float*)(F.lds + TILE_B);
    const int cc = (tid & 15) * 8, chg = n * 128 + cc, trow = tid >> 4;
    const int fr = lane & 15, fq = lane >> 4, chw = 16 * wave + fr;
    u32x4 xr[4][4];
#pragma unroll
    for (int p = 0; p < 4; ++p)
#pragma unroll
        for (int k = 0; k < 4; ++k) { const int ts = t0 + p * 32 + trow - 3 + k, tc = ts < 0 ? 0 : ts; xr[p][k] = *(const u32x4*)(PROJ + (size_t)tc * NP + C_XC + chg); }
    bf16x8 wrf[4], wif[4];
    { const bf16_t* RWT = (const bf16_t*)(F.ws + WS_RWT) + ((size_t)l * 8 + n) * 256 * 128 + (size_t)chw * 128 + 8 * fq;
#pragma unroll
      for (int kk = 0; kk < 4; ++kk) { wrf[kk] = *(const bf16x8*)(RWT + kk * 32); wif[kk] = *(const bf16x8*)(RWT + 128 * 128 + kk * 32); } }
    float cwv[4][8], cbv[8];
    { const float* cw = in_ptr(10) + (size_t)l * 4 * BW + chg; const float* cb = in_ptr(11) + (size_t)l * BW + chg;
#pragma unroll
      for (int k = 0; k < 4; ++k) { const f32x4 a4 = *(const f32x4*)(cw + k * BW), b4 = *(const f32x4*)(cw + k * BW + 4);
#pragma unroll
        for (int j = 0; j < 4; ++j) { cwv[k][j] = a4[j]; cwv[k][4 + j] = b4[j]; } }
      const f32x4 c0 = *(const f32x4*)cb, c1 = *(const f32x4*)(cb + 4);
#pragma unroll
      for (int j = 0; j < 4; ++j) { cbv[j] = c0[j]; cbv[4 + j] = c1[j]; } }
    const float spl = ((const float*)(F.ws + WS_SPL))[(size_t)l * BW + n * 128 + chw];
    const float brc = in_ptr(13)[(size_t)l * 2 * BW + n * 128 + chw], bic = in_ptr(13)[(size_t)l * 2 * BW + BW + n * 128 + chw];
    __syncthreads();
#pragma unroll
    for (int p = 0; p < 4; ++p) { const int t = p * 32 + trow; float xv[8];
#pragma unroll
        for (int j = 0; j < 8; ++j) xv[j] = cbv[j];
#pragma unroll
        for (int k = 0; k < 4; ++k) { const float msk = (t0 + t - 3 + k >= 0) ? 1.0f : 0.0f; float f[8]; unpack8(xr[p][k], f);
#pragma unroll
            for (int j = 0; j < 8; ++j) xv[j] += (msk * cwv[k][j]) * f[j]; }
        *(LAS u32x4*)(Xs + t * TP + cc * 2) = pack8(xv);
        *(LAS f32x4*)(XF + t * SP + cc) = (f32x4){xv[0], xv[1], xv[2], xv[3]}; *(LAS f32x4*)(XF + t * SP + cc + 4) = (f32x4){xv[4], xv[5], xv[6], xv[7]}; }
    __syncthreads();
    f32x4 gr[8], gi[8];
#pragma unroll
    for (int mi = 0; mi < 8; ++mi) { gr[mi] = (f32x4){0.f, 0.f, 0.f, 0.f}; gi[mi] = (f32x4){0.f, 0.f, 0.f, 0.f};
#pragma unroll
        for (int kk = 0; kk < 4; ++kk) { const bf16x8 xa = frag_row(Xs, TP, 16 * mi, kk * 32, lane);
            gr[mi] = __builtin_amdgcn_mfma_f32_16x16x32_bf16(xa, wrf[kk], gr[mi], 0, 0, 0);
            gi[mi] = __builtin_amdgcn_mfma_f32_16x16x32_bf16(xa, wif[kk], gi[mi], 0, 0, 0); } }
#pragma unroll
    for (int mi = 0; mi < 8; ++mi)
#pragma unroll
        for (int r = 0; r < 4; ++r) { const int t = 16 * mi + 4 * fq + r; const float xvv = XF[t * SP + chw];
            const float rg = sigmoidf_(gr[mi][r] + brc), ig = sigmoidf_(gi[mi][r] + bic);
            const float la = rg * spl; const float av = __builtin_amdgcn_exp2f(1.44269504f * la);
            const float x2 = 2.0f * la;
            const float ser = -x2 * (1.0f + x2 * (0.5f + x2 * (0.16666667f + x2 * (0.041666668f + x2 * (0.0083333338f + x2 * 0.0013888889f)))));
            const float em = (x2 > -0.5f) ? ser : (1.0f - av * av);
            float mult = __builtin_amdgcn_sqrtf(fmaxf(em, 0.f)); if (t0 + t == 0) mult = 1.0f;
            gr[mi][r] = av; gi[mi][r] = mult * ig * xvv; }
    float Ac = 1.f, hc = 0.f;
#pragma unroll
    for (int mi = 0; mi < 8; ++mi) {
        float al[4], hl[4]; float A = 1.f, hh = 0.f;
#pragma unroll
        for (int r = 0; r < 4; ++r) { hh = gr[mi][r] * hh + gi[mi][r]; A *= gr[mi][r]; al[r] = A; hl[r] = hh; }
        float Ai = A, hi = hh;
        { const float Ap = __shfl_up(Ai, 16), hp = __shfl_up(hi, 16); if (fq >= 1) { hi = Ai * hp + hi; Ai = Ai * Ap; } }
        { const float Ap = __shfl_up(Ai, 32), hp = __shfl_up(hi, 32); if (fq >= 2) { hi = Ai * hp + hi; Ai = Ai * Ap; } }
        float Ae = __shfl_up(Ai, 16), he = __shfl_up(hi, 16); if (fq == 0) { Ae = 1.f; he = 0.f; }
        const float At = __shfl(Ai, fr + 48), ht = __shfl(hi, fr + 48);
        const float As = Ac * Ae, hs = Ae * hc + he;
#pragma unroll
        for (int r = 0; r < 4; ++r) { gr[mi][r] = al[r] * hs + hl[r]; gi[mi][r] = As * al[r]; }
        hc = At * hc + ht; Ac = Ac * At;
    }
    if (fq == 0) { float* AP = (float*)(F.ws + WS_APROD); AP[c * BW + n * 128 + chw] = Ac; AP[65536 + c * BW + n * 128 + chw] = hc; }
    bf16_t* HL = (bf16_t*)(F.ws + WS_HLOC); bf16_t* AC = (bf16_t*)(F.ws + WS_ACUM);
#pragma unroll
    for (int which = 0; which < 2; ++which) {
        asm volatile("s_waitcnt lgkmcnt(0)" ::: "memory");
#pragma unroll
        for (int mi = 0; mi < 8; ++mi)
#pragma unroll
            for (int r = 0; r < 4; ++r) XF[(16 * mi + 4 * fq + r) * SP + chw] = which == 0 ? gr[mi][r] : gi[mi][r];
        asm volatile("s_waitcnt lgkmcnt(0)" ::: "memory");
#pragma unroll
        for (int i = 0; i < 4; ++i) { const int idx = lane + 64 * i, row = idx >> 1, c8 = idx & 1;
            const f32x4 x0 = *(const LAS f32x4*)(XF + row * SP + 16 * wave + 8 * c8), x1 = *(const LAS f32x4*)(XF + row * SP + 16 * wave + 8 * c8 + 4);
            float v8[8];
#pragma unroll
            for (int j = 0; j < 4; ++j) { v8[j] = x0[j]; v8[4 + j] = x1[j]; }
            *(u32x4*)((which == 0 ? HL : AC) + (size_t)(t0 + row) * BW + n * 128 + 16 * wave + 8 * c8) = pack8(v8); }
    }
}
__device__ __forceinline__ void rglru_c3(Frame& F, int unit) {
    PHASE_TID();
    const int c = unit >> 3, n = unit & 7, t0 = c * LCH;
    const bf16_t* PROJ = (const bf16_t*)(F.ws + WS_PROJ);
    const bf16_t* HL = (const bf16_t*)(F.ws + WS_HLOC); const bf16_t* AC = (const bf16_t*)(F.ws + WS_ACUM); bf16_t* YS = (bf16_t*)(F.ws + WS_YS);
    LAS float* sCarry = (LAS float*)(F.lds + SCAL_OFF);
    u32x4 hv[4], av[4], zv[4];
#pragma unroll
    for (int p = 0; p < 4; ++p) { const int t = p * 32 + (tid >> 4), cc = (tid & 15) * 8; const size_t o = (size_t)(t0 + t) * BW + n * 128 + cc;
        hv[p] = *(const u32x4*)(HL + o); av[p] = *(const u32x4*)(AC + o); zv[p] = *(const u32x4*)(PROJ + (size_t)(t0 + t) * NP + C_ZC + n * 128 + cc); }
    __syncthreads();
    if (tid < 128) { const float* AP = (const float*)(F.ws + WS_APROD) + n * 128 + tid; float carry = 0.f;
        int cp = 0;
        for (; cp + 8 <= c; cp += 8) { float a[8], hl[8];
#pragma unroll
            for (int j = 0; j < 8; ++j) { a[j] = AP[(cp + j) * BW]; hl[j] = AP[65536 + (cp + j) * BW]; }
#pragma unroll
            for (int j = 0; j < 8; ++j) carry = a[j] * carry + hl[j]; }
        for (; cp < c; ++cp) carry = AP[cp * BW] * carry + AP[65536 + cp * BW];
        sCarry[tid] = carry; }
    __syncthreads();
#pragma unroll
    for (int p = 0; p < 4; ++p) { const int t = p * 32 + (tid >> 4), cc = (tid & 15) * 8;
        float hf[8], af[8], zf[8]; unpack8(hv[p], hf); unpack8(av[p], af); unpack8(zv[p], zf);
        float y[8];
#pragma unroll
        for (int j = 0; j < 8; ++j) y[j] = (hf[j] + af[j] * sCarry[cc + j]) * zf[j];
        *(u32x4*)(YS + (size_t)(t0 + t) * DM + 2 * BW + n * 128 + cc) = pack8(y); }
}
__global__ void __launch_bounds__(512, 2) hybrid_fwd(Args args) {
    extern __shared__ __attribute__((aligned(16))) unsigned char lds_raw[];
    Frame F;
    F.lds = (lds_u8*)lds_raw;
    F.G = gridDim.x; F.bid = blockIdx.x;
    F.ws = args.ws;
    volatile LAS unsigned* MISC = (volatile LAS unsigned*)(F.lds + MISC_OFF);
    if (threadIdx.x < 64) MISC[threadIdx.x] = 0u;
    __syncthreads();
    XcdBarrier bar = xcd_barrier_post((unsigned*)(F.ws + WS_CTL) + CW_BAR, MISC + 8);
#define GRID_BAR() xcd_barrier(bar)

    for (int l = 0; l <= DEPTH; ++l) {
        for (int rep = 0; rep < REP_NORM; ++rep) norm_phase(F, l);
        if (l == DEPTH) break;
        if (l == 0) { for (int rep = 0; rep < REP_P0; ++rep) { p0_win0_tiles(F, 0, T0_TILES, F.bid, F.G * 8, false); p0_prologue(F, 0, 1, 4); } }
        GRID_BAR();
        for (int rep = 0; rep < REP_B; ++rep) {
            pg8::Gemm g{(const bf16_t*)(F.ws + WS_H), (const bf16_t*)(F.ws + WS_WIN + (size_t)l * WIN_L), DM, DM, DM};
            pg8::StaticOrder S; S.init(SEQ, NP, F.G, F.bid, 1);
            pg8::EpiProj E{(bf16_t*)(F.ws + WS_PROJ), F.lds + pg8::STAGE_BYTES, 0};
            const bool slotted = (l == 0 && rep == 0);
            const int cp = slotted ? (F.bid & 7) : (1 << 30);
            S.remap8 = 1;
            if (slotted) { g.tcnt = (unsigned*)(F.ws + WS_CTL) + CW_TCNT; g.bar = (unsigned*)(F.ws + WS_CTL) + CW_BAR; }
            for (int part = 0; part < 2; ++part) {
                if (part == 1) { if (!slotted) break;
                    __syncthreads();
                    p0_win0_tiles(F, T0_TILES + SLOT_TILES * (F.bid & 7), T0_TILES + SLOT_TILES * ((F.bid & 7) + 1), F.bid >> 3, (F.G >> 3) * 8, true);
                    p0_prologue(F, 0, 1, 2); p0_prologue(F, 1, DEPTH, 7);
                    if ((threadIdx.x >> 6) == 0) {
                        for (int k = 0; k < 2; ++k) { pg8::Unit u2; if (S.at(cp + k, u2) && u2.pn >= T0_TILES) { unsigned* w = g.tcnt + 64 * u2.pn; unsigned sp = 0;
                            while ((unsigned)__builtin_amdgcn_readfirstlane(xb_ld(w)) != 256u) { __builtin_amdgcn_s_sleep(2);
                                if ((++sp & 255u) == 0u) { if (xb_ld(&g.bar[XB_TMO])) break; if (sp > XB_SPIN_CAP) { atomicAdd(&g.bar[XB_TMO], 1u); break; } } } } }
                        __builtin_amdgcn_fence(__ATOMIC_ACQUIRE, "agent"); }
                    __syncthreads(); }
                S.i0 = part == 0 ? 0 : cp; S.i1 = part == 0 ? cp : (1 << 30);
                pg8::gemm_phase<pg8::EpiProj>(F.lds, g, S, E, STAG_B);
            }
            GRID_BAR();
        }
        for (int rep = 0; rep < REP_MIX; ++rep) {
        for (int r1 = 0; r1 < REP_C1; ++r1) {
        for (int q = 0; q < REP_U1; ++q) for (int u = F.bid; u < 512; u += F.G) mlstm_c1(F, u, l);
        for (int q = 0; q < REP_U2; ++q) for (int u = F.bid; u < 512; u += F.G) rglru_c1(F, u, l);
        gmlp_stats(F);
        GRID_BAR();
        }
        for (int r2 = 0; r2 < REP_C2; ++r2) {
        mlstm_c2(F);
        for (int q = 0; q < REP_U3; ++q) for (int u = F.bid; u < 512; u += F.G) gmlp_unit(F, u, l);
        GRID_BAR();
        }
        for (int r3 = 0; r3 < REP_C3; ++r3) {
        for (int u = F.bid; u < 512; u += F.G) mlstm_c3(F, u, l);
        for (int u = F.bid; u < 512; u += F.G) rglru_c3(F, u);
        GRID_BAR();
        }
        }
        for (int rep = 0; rep < REP_D; ++rep) {
            pg8::Gemm g{(const bf16_t*)(F.ws + WS_YS), (const bf16_t*)(F.ws + WS_WBR + (size_t)l * WSQ_L), DM, DM, BW};
            pg8::StaticOrder S; S.init(SEQ, DM, F.G, F.bid, 4);
            pg8::EpiMerge E{(const bf16_t*)(F.ws + WS_PROJ) + C_G, (bf16_t*)(F.ws + WS_MERGED), 0};
            __syncthreads();
            pg8::gemm_phase<pg8::EpiMerge>(F.lds, g, S, E, STAG_D);
            GRID_BAR();
        }
        for (int rep = 0; rep < REP_E; ++rep) {
            pg8::Gemm g{(const bf16_t*)(F.ws + WS_MERGED), (const bf16_t*)(F.ws + WS_WOUT + (size_t)l * WSQ_L), DM, DM, DM};
            pg8::StaticOrder S; S.init(SEQ, DM, F.G, F.bid, 1);
            pg8::EpiOut E{(bf16_t*)(F.ws + WS_OUT + (size_t)l * OUT_L), (float*)(F.ws + (l == 0 ? WS_SS : WS_SS1))};
            pg8::gemm_phase<pg8::EpiOut>(F.lds, g, S, E, STAG_E);
            GRID_BAR();
        }
    }
#if PROBE_TAIL >= 10
    {
        GRID_BAR();
        pg8::Gemm g{(const bf16_t*)(F.ws + WS_YS), (const bf16_t*)(F.ws + WS_WBR + WSQ_L), DM, DM, BW};
        pg8::StaticOrder S; S.init(SEQ, DM, F.G, F.bid, 4);
        pg8::EpiMerge E{(const bf16_t*)(F.ws + WS_PROJ) + C_G, (bf16_t*)(F.ws + WS_MERGED), PROBE_TAIL - 10};
        pg8::gemm_phase<pg8::EpiMerge>(F.lds, g, S, E, 0);
    }
#elif PROBE_TAIL
    {
        GRID_BAR();
        pg8::Gemm g{(const bf16_t*)(F.ws + WS_H), (const bf16_t*)(F.ws + WS_WIN + WIN_L), DM, DM, DM};
        pg8::StaticOrder S; S.init(SEQ, NP, F.G, F.bid, 1); S.same = (PROBE_TAIL == 1);
        pg8::EpiProj E{(bf16_t*)(F.ws + WS_PROJ), F.lds + pg8::STAGE_BYTES, PROBE_TAIL == 2 ? 1 : (PROBE_TAIL >= 3 ? PROBE_TAIL : 0)};
        pg8::gemm_phase<pg8::EpiProj>(F.lds, g, S, E, STAG_B);
    }
#endif
}

extern "C" void kernel_launch(void* const* d_in, const int* in_sizes, int n_in, void* d_out, int out_size, void* d_ws, size_t ws_size, hipStream_t stream) {
    static int grid = 0;
    if (grid == 0) {
        if (n_in != 18 || in_sizes[0] != SEQ * DM || out_size != SEQ * DM || ws_size < WS_END) {
            fprintf(stderr, "kernel_launch: unexpected problem: n_in %d in0 %d out %d ws %zu (need %zu)\n", n_in, n_in > 0 ? in_sizes[0] : -1, out_size, ws_size, (size_t)WS_END); grid = -1; return; }
        int dev = 0, cus = 0, per_cu = 0;
        if (hipGetDevice(&dev) != hipSuccess || hipDeviceGetAttribute(&cus, hipDeviceAttributeMultiprocessorCount, dev) != hipSuccess) { fprintf(stderr, "kernel_launch: device query failed\n"); grid = -1; return; }
        if (hipFuncSetAttribute((const void*)hybrid_fwd, hipFuncAttributeMaxDynamicSharedMemorySize, LDS_BYTES) != hipSuccess) { fprintf(stderr, "kernel_launch: hipFuncSetAttribute failed\n"); grid = -1; return; }
        if (hipOccupancyMaxActiveBlocksPerMultiprocessor(&per_cu, (const void*)hybrid_fwd, 512, LDS_BYTES) != hipSuccess || per_cu < 1)
            fprintf(stderr, "kernel_launch: note: occupancy query reports %d workgroups per CU\n", per_cu);
        (void)hipGetLastError();
        grid = cus;
    }
    if (grid < 0) return;
    if (hipMemsetAsync((char*)d_ws + WS_CTL, 0, CTL_ZERO_BYTES, stream) != hipSuccess) { fprintf(stderr, "kernel_launch: memset failed\n"); return; }
    Args a{};
    for (int i = 0; i < 18; ++i) a.in[i] = (const float*)d_in[i];
    a.out = (float*)d_out; a.ws = (unsigned char*)d_ws;
    hipLaunchKernelGGL(hybrid_fwd, dim3(grid), dim3(512), LDS_BYTES, stream, a);
    const hipError_t le = hipPeekAtLastError();
    if (le != hipSuccess) fprintf(stderr, "kernel_launch: launch failed: %s\n", hipGetErrorName(le));
}
```
